# Optimizing an MI355X kernel written in HIP

```python
import math
import jax, jax.numpy as jnp
from jax import lax
import numpy as np

D_MODEL = 1024
BATCH = 16
SEQ = 4096
DEPTH = 4
DEC_BATCH = 4
DEC_SEQ = 8192
PAST_LEN = 128

N_MIXERS = 2
N_GLA_LAYERS = (DEPTH + N_MIXERS - 1) // N_MIXERS
N_MLA_LAYERS = DEPTH // N_MIXERS
D_FF = 2816
RES_HALF = 0.5
N_MOD = 9
EPS = 1e-6
GLA_HEADS = 4
GLA_DK = D_MODEL // 2 // GLA_HEADS
GLA_DV = D_MODEL // GLA_HEADS
GLA_GATE_RANK = 16
GLA_TAU = 16.0
GLA_CHUNK = 64
GLA_QK = GLA_HEADS * GLA_DK
GLA_VR = GLA_HEADS * GLA_DV
GLA_IN = 2 * GLA_QK + 2 * GLA_VR + 2 * GLA_GATE_RANK
MLA_HEADS = 8
MLA_NOPE = 128
MLA_ROPE = 64
MLA_V = 128
MLA_Q_RANK = 256
MLA_KV_RANK = 128
MLA_IN = MLA_Q_RANK + MLA_KV_RANK + MLA_ROPE
ROPE_THETA = 10000.0
Q_BLOCK = 128

kernel_name = 'hybrid_gla_mla_macaron_adaln_encoder'


def rms_norm(x, g):
    xf = x.astype(jnp.float32)
    y = xf * lax.rsqrt(jnp.mean(xf * xf, axis=-1, keepdims=True) + EPS)
    return (y * g.astype(jnp.float32)).astype(x.dtype)


def modulate(h, shift, scale):
    return h * (1 + scale[:, None, :]) + shift[:, None, :]


def swiglu_ffn(h, w_gate, w_up, w_down):
    return (jax.nn.silu(h @ w_gate) * (h @ w_up)) @ w_down


def gla_chunked(q, k, v, log_a):
    B, H, S, dk = q.shape
    dv = v.shape[-1]
    n = S // GLA_CHUNK

    def chunks(t):
        return t.reshape(B, H, n, GLA_CHUNK, t.shape[-1])

    q, k, v, log_a = chunks(q), chunks(k), chunks(v), chunks(log_a)
    b = lax.cumsum(log_a, axis=3)
    b_last = b[:, :, :, -1:, :]
    q_in = q * jnp.exp(b)
    k_in = k * jnp.exp(-b)
    k_out = k * jnp.exp(b_last - b)
    lower_tri = jnp.tril(jnp.ones((GLA_CHUNK, GLA_CHUNK), dtype=bool))
    a = jnp.einsum('bhnid,bhnjd->bhnij', q_in, k_in)
    a = jnp.where(lower_tri, a, 0.0)
    o_intra = jnp.einsum('bhnij,bhnjv->bhniv', a, v)

    def step(state, inp):
        q_c, k_c, v_c, decay = inp
        o_c = jnp.einsum('bhid,bhdv->bhiv', q_c, state)
        state = state * decay[..., None] + jnp.einsum('bhjd,bhjv->bhdv', k_c, v_c)
        return state, o_c

    decay = jnp.exp(b_last[:, :, :, 0, :])
    xs = (jnp.moveaxis(q_in, 2, 0), jnp.moveaxis(k_out, 2, 0),
          jnp.moveaxis(v, 2, 0), jnp.moveaxis(decay, 2, 0))
    state0 = jnp.zeros((B, H, dk, dv), jnp.float32)
    _, o_inter = lax.scan(step, state0, xs)
    o = o_intra + jnp.moveaxis(o_inter, 0, 2)
    return o.reshape(B, H, S, dv)


def gla_mixer(h, w_in, w_gate_up, b_gate, g_norm, w_out):
    B, S, _ = h.shape
    proj = h @ w_in
    cuts = [GLA_QK, 2 * GLA_QK, 2 * GLA_QK + GLA_VR, 2 * GLA_QK + 2 * GLA_VR,
            2 * GLA_QK + 2 * GLA_VR + GLA_GATE_RANK]
    q, k, v, r, a_fwd, a_bwd = jnp.split(proj, cuts, axis=-1)

    def heads(t, d):
        return t.reshape(B, S, GLA_HEADS, d).transpose(0, 2, 1, 3).astype(jnp.float32)

    q = heads(q, GLA_DK) * (GLA_DK ** -0.5)
    k = heads(k, GLA_DK)
    v = heads(v, GLA_DV)

    def log_gate(a_low, w_up, b):
        logits = (a_low @ w_up + b).astype(jnp.float32)
        return heads(jax.nn.log_sigmoid(logits) / GLA_TAU, GLA_DK)

    la_fwd = log_gate(a_fwd, w_gate_up[0], b_gate[0])
    la_bwd = log_gate(a_bwd, w_gate_up[1], b_gate[1])
    o_fwd = gla_chunked(q, k, v, la_fwd)
    flip = lambda t: jnp.flip(t, axis=2)
    o_bwd = flip(gla_chunked(flip(q), flip(k), flip(v), flip(la_bwd)))
    o = (o_fwd + o_bwd).transpose(0, 2, 1, 3)
    o = rms_norm(o, g_norm).reshape(B, S, GLA_VR).astype(h.dtype)
    return (jax.nn.silu(r) * o) @ w_out


def rope_tables(S):
    inv = 1.0 / (ROPE_THETA ** (jnp.arange(0, MLA_ROPE, 2, dtype=jnp.float32) / MLA_ROPE))
    ang = jnp.arange(S, dtype=jnp.float32)[:, None] * inv[None, :]
    return jnp.cos(ang)[:, None, :], jnp.sin(ang)[:, None, :]


def apply_rope(x, cos, sin):
    half = MLA_ROPE // 2
    x1, x2 = x[..., :half], x[..., half:]
    out = jnp.concatenate([x1 * cos - x2 * sin, x1 * sin + x2 * cos], axis=-1)
    return out.astype(x.dtype)


def mla_mixer(h, w_in, g_q, g_kv, w_uq, w_ukv, w_out):
    B, S, _ = h.shape
    c_q, c_kv, k_rope = jnp.split(h @ w_in, [MLA_Q_RANK, MLA_Q_RANK + MLA_KV_RANK], axis=-1)
    c_q = rms_norm(c_q, g_q)
    c_kv = rms_norm(c_kv, g_kv)
    q = (c_q @ w_uq).reshape(B, S, MLA_HEADS, MLA_NOPE + MLA_ROPE)
    q_nope, q_rope = q[..., :MLA_NOPE], q[..., MLA_NOPE:]
    kv = (c_kv @ w_ukv).reshape(B, S, MLA_HEADS, MLA_NOPE + MLA_V)
    k_nope, v = kv[..., :MLA_NOPE], kv[..., MLA_NOPE:]
    cos, sin = rope_tables(S)
    q_rope = apply_rope(q_rope, cos, sin)
    k_rope = apply_rope(k_rope[:, :, None, :], cos, sin)[:, :, 0, :]
    scale = (MLA_NOPE + MLA_ROPE) ** -0.5
    nb = S // Q_BLOCK

    def blocks(t):
        return jnp.moveaxis(t.reshape(B, nb, Q_BLOCK, MLA_HEADS, t.shape[-1]), 1, 0)

    def attend(qs):
        qn, qr = qs
        s = (jnp.einsum('bqhd,bkhd->bhqk', qn, k_nope, preferred_element_type=jnp.float32)
             + jnp.einsum('bqhr,bkr->bhqk', qr, k_rope, preferred_element_type=jnp.float32)) * scale
        p = jax.nn.softmax(s, axis=-1).astype(v.dtype)
        return jnp.einsum('bhqk,bkhd->bqhd', p, v)

    o = lax.map(attend, (blocks(q_nope), blocks(q_rope)))
    o = jnp.moveaxis(o, 0, 1).reshape(B, S, MLA_HEADS * MLA_V)
    return o @ w_out


def trunk(x, c, ada_w, ada_b, norm_g, ffn_w_gate, ffn_w_up, ffn_w_down,
          gla_w_in, gla_w_gate_up, gla_b_gate, gla_g_norm, gla_w_out,
          mla_w_in, mla_g_q, mla_g_kv, mla_w_uq, mla_w_ukv, mla_w_out,
          final_ada_w, final_ada_b, final_g):
    c_act = jax.nn.silu(c)
    for i in range(DEPTH):
        mod = c_act @ ada_w[i] + ada_b[i]
        s1, sc1, g1, sm, scm, gm, s2, sc2, g2 = jnp.split(mod, N_MOD, axis=-1)
        h = modulate(rms_norm(x, norm_g[i, 0]), s1, sc1)
        x = x + RES_HALF * g1[:, None, :] * swiglu_ffn(h, ffn_w_gate[i, 0], ffn_w_up[i, 0], ffn_w_down[i, 0])
        h = modulate(rms_norm(x, norm_g[i, 1]), sm, scm)
        j = i // N_MIXERS
        if i % N_MIXERS == 0:
            y = gla_mixer(h, gla_w_in[j], gla_w_gate_up[j], gla_b_gate[j], gla_g_norm[j], gla_w_out[j])
        else:
            y = mla_mixer(h, mla_w_in[j], mla_g_q[j], mla_g_kv[j], mla_w_uq[j], mla_w_ukv[j], mla_w_out[j])
        x = x + gm[:, None, :] * y
        h = modulate(rms_norm(x, norm_g[i, 2]), s2, sc2)
        x = x + RES_HALF * g2[:, None, :] * swiglu_ffn(h, ffn_w_gate[i, 1], ffn_w_up[i, 1], ffn_w_down[i, 1])
    fin_shift, fin_scale = jnp.split(c_act @ final_ada_w + final_ada_b, 2, axis=-1)
    return modulate(rms_norm(x, final_g), fin_shift, fin_scale)


def setup_inputs(seed: int = 0) -> dict:
    key = jax.random.key(seed)
    ks = jax.random.split(key, 24)
    f32 = jnp.float32

    def w(k, shape, fan_in):
        return jax.random.normal(k, shape, f32) * (fan_in ** -0.5)

    def gain(k, shape):
        return 1.0 + 0.02 * jax.random.normal(k, shape, f32)

    def bias(k, shape):
        return 0.02 * jax.random.normal(k, shape, f32)

    D = D_MODEL
    return {
        'x_prompt': jax.random.normal(ks[0], (BATCH, SEQ, D), f32),
        'x_sample': jax.random.normal(ks[1], (DEC_BATCH, DEC_SEQ, D), f32),
        'c_prompt': jax.random.normal(ks[2], (BATCH, D), f32),
        'c_sample': jax.random.normal(ks[3], (DEC_BATCH, D), f32),
        'ada_w': w(ks[4], (DEPTH, D, N_MOD * D), D),
        'ada_b': bias(ks[5], (DEPTH, N_MOD * D)),
        'norm_g': gain(ks[6], (DEPTH, 3, D)),
        'ffn_w_gate': w(ks[7], (DEPTH, 2, D, D_FF), D),
        'ffn_w_up': w(ks[8], (DEPTH, 2, D, D_FF), D),
        'ffn_w_down': w(ks[9], (DEPTH, 2, D_FF, D), D_FF),
        'gla_w_in': w(ks[10], (N_GLA_LAYERS, D, GLA_IN), D),
        'gla_w_gate_up': w(ks[11], (N_GLA_LAYERS, 2, GLA_GATE_RANK, GLA_QK), GLA_GATE_RANK),
        'gla_b_gate': bias(ks[12], (N_GLA_LAYERS, 2, GLA_QK)),
        'gla_g_norm': gain(ks[13], (N_GLA_LAYERS, GLA_DV)),
        'gla_w_out': w(ks[14], (N_GLA_LAYERS, GLA_VR, D), GLA_VR),
        'mla_w_in': w(ks[15], (N_MLA_LAYERS, D, MLA_IN), D),
        'mla_g_q': gain(ks[16], (N_MLA_LAYERS, MLA_Q_RANK)),
        'mla_g_kv': gain(ks[17], (N_MLA_LAYERS, MLA_KV_RANK)),
        'mla_w_uq': w(ks[18], (N_MLA_LAYERS, MLA_Q_RANK, MLA_HEADS * (MLA_NOPE + MLA_ROPE)), MLA_Q_RANK),
        'mla_w_ukv': w(ks[19], (N_MLA_LAYERS, MLA_KV_RANK, MLA_HEADS * (MLA_NOPE + MLA_V)), MLA_KV_RANK),
        'mla_w_out': w(ks[20], (N_MLA_LAYERS, MLA_HEADS * MLA_V, D), MLA_HEADS * MLA_V),
        'final_ada_w': w(ks[21], (D, 2 * D), D),
        'final_ada_b': bias(ks[22], (2 * D,)),
        'final_g': gain(ks[23], (D,)),
    }


def reference(x_prompt, x_sample, c_prompt, c_sample, ada_w, ada_b, norm_g,
              ffn_w_gate, ffn_w_up, ffn_w_down,
              gla_w_in, gla_w_gate_up, gla_b_gate, gla_g_norm, gla_w_out,
              mla_w_in, mla_g_q, mla_g_kv, mla_w_uq, mla_w_ukv, mla_w_out,
              final_ada_w, final_ada_b, final_g):
    y_prompt = trunk(x_prompt, c_prompt, ada_w, ada_b, norm_g, ffn_w_gate, ffn_w_up, ffn_w_down,
                     gla_w_in, gla_w_gate_up, gla_b_gate, gla_g_norm, gla_w_out,
                     mla_w_in, mla_g_q, mla_g_kv, mla_w_uq, mla_w_ukv, mla_w_out,
                     final_ada_w, final_ada_b, final_g)
    y_sample = trunk(x_sample, c_sample, ada_w, ada_b, norm_g, ffn_w_gate, ffn_w_up, ffn_w_down,
                     gla_w_in, gla_w_gate_up, gla_b_gate, gla_g_norm, gla_w_out,
                     mla_w_in, mla_g_q, mla_g_kv, mla_w_uq, mla_w_ukv, mla_w_out,
                     final_ada_w, final_ada_b, final_g)
    return (y_prompt, y_sample)
```

```cpp
#include <hip/hip_runtime.h>
#include <hip/hip_cooperative_groups.h>
#include <cstdio>
#include <cstdint>
namespace cg = cooperative_groups;

#define LAS __attribute__((address_space(3)))
typedef unsigned short bf16_t;
typedef short bf16x8 __attribute__((ext_vector_type(8)));
typedef short s16x4 __attribute__((ext_vector_type(4)));
typedef float f32x4 __attribute__((ext_vector_type(4)));
typedef float f32x2 __attribute__((ext_vector_type(2)));
typedef float f32x16 __attribute__((ext_vector_type(16)));
typedef unsigned u32x4 __attribute__((ext_vector_type(4)));
typedef unsigned u32x2 __attribute__((ext_vector_type(2)));

constexpr int T_ALL = 98304, TG = 49152, DM = 1024, DFF = 2816, NSEQ = 20, MODW = 9216;
constexpr float EPS = 1e-6f;
constexpr size_t XP_ELEMS = 16ull * 4096 * 1024;

constexpr size_t SZ_GU = 5632ull * 1024, SZ_DN = 1024ull * 2816, W_FFN_STRIDE = SZ_GU + SZ_DN, W_FFN_TOTAL = 8 * W_FFN_STRIDE;
constexpr size_t SZ_GIN = 3328ull * 1024, SZ_GOUT = 1024ull * 1024, SZ_MIN = 512ull * 1024, SZ_UQ = 1536ull * 256, SZ_UKV = 2048ull * 256, SZ_MOUT = 1024ull * 1024;
constexpr size_t W_MIX_STRIDE = SZ_GIN + SZ_GOUT + SZ_MIN + SZ_UQ + SZ_UKV + SZ_MOUT;
constexpr size_t W_TOTAL = W_FFN_TOTAL + 2 * W_MIX_STRIDE;
constexpr size_t OFF_W = 0;
constexpr size_t OFF_MOD = OFF_W + W_TOTAL * 2;
constexpr size_t MOD_FLOATS = 4ull * NSEQ * MODW + (size_t)NSEQ * 2048;
constexpr size_t OFF_ROPE = OFF_MOD + MOD_FLOATS * 4;
constexpr size_t OFF_H = OFF_ROPE + 8192ull * 32 * 8;
constexpr size_t OFF_ACT = OFF_H + (size_t)T_ALL * 1024 * 2;
constexpr size_t OFF_BAR = OFF_ACT + (size_t)T_ALL * DFF * 2;
constexpr size_t OFF_SSQ = OFF_BAR + 16384;
constexpr size_t OFF_TB = OFF_SSQ + 2ull * T_ALL * 16 * 4;
constexpr size_t TB_FFN_SZ = 20ull * 5632, TB_PROJ_SZ = 20ull * 3328, TB_CIN_SZ = 20ull * 512;
constexpr size_t TB_FLOATS = 8 * TB_FFN_SZ + 2 * TB_PROJ_SZ + 2 * TB_CIN_SZ;
constexpr size_t WS_NEED = OFF_TB + TB_FLOATS * 4;
static_assert(OFF_MOD % 256 == 0 && OFF_ROPE % 256 == 0 && OFF_H % 256 == 0 && OFF_ACT % 256 == 0, "align");
constexpr size_t GLA_PROJ = 0, GLA_OF = GLA_PROJ + (size_t)TG * 3328 * 2, GLA_OB = GLA_OF + (size_t)TG * 1024 * 2, GLA_END = GLA_OB + (size_t)TG * 1024 * 2;
constexpr size_t MLA_O = 0;
constexpr size_t MLA_CIN = 0, MLA_CN = MLA_CIN + (size_t)TG * 512 * 2, MLA_KR = MLA_CN + (size_t)TG * 512 * 2, MLA_Q = MLA_KR + (size_t)TG * 64 * 2,
                 MLA_KN = MLA_Q + (size_t)TG * 1536 * 2, MLA_V = MLA_KN + (size_t)TG * 1024 * 2, MLA_END = MLA_V + (size_t)TG * 1024 * 2;
static_assert(GLA_END <= (size_t)T_ALL * DFF * 2 && MLA_END <= (size_t)T_ALL * DFF * 2, "act region");

constexpr int LDS_MAIN = 131072, LDS_BYTES = LDS_MAIN + 16;

struct Params {
    const float* in[24];
    float* out;
    unsigned char* ws;
};

__device__ __forceinline__ int opaque_tid() { int t = threadIdx.x; asm volatile("" : "+v"(t)); return t; }
__device__ __forceinline__ int opaque_bid() { int b = blockIdx.x; asm volatile("" : "+s"(b)); return b; }
__device__ __forceinline__ float bf2f(bf16_t b) { return __uint_as_float(((unsigned)b) << 16); }
typedef __bf16 bf16v2 __attribute__((ext_vector_type(2)));
__device__ __forceinline__ bf16_t f2bf(float f) { return __builtin_bit_cast(bf16_t, (__bf16)f); }
__device__ __forceinline__ unsigned cvt_pk_bf16(float lo, float hi) { f32x2 v = {lo, hi}; bf16v2 b = __builtin_convertvector(v, bf16v2); return __builtin_bit_cast(unsigned, b); }
template <int M> __device__ __forceinline__ float swz_xor(float x) { return __int_as_float(__builtin_amdgcn_ds_swizzle(__float_as_int(x), (M << 10) | 0x1F)); }
__device__ __forceinline__ float sum_xor32(float x) { auto rr = __builtin_amdgcn_permlane32_swap(__float_as_uint(x), __float_as_uint(x), false, false); return __uint_as_float(rr[0]) + __uint_as_float(rr[1]); }
__device__ __forceinline__ float get_xor32(float x, int hi) { auto rr = __builtin_amdgcn_permlane32_swap(__float_as_uint(x), __float_as_uint(x), false, false); return hi ? __uint_as_float(rr[0]) : __uint_as_float(rr[1]); }
__device__ __forceinline__ float wave_sum(float x) { x += swz_xor<1>(x); x += swz_xor<2>(x); x += swz_xor<4>(x); x += swz_xor<8>(x); x += swz_xor<16>(x); return sum_xor32(x); }
__device__ __forceinline__ int tok_batch(int t) { return t < 65536 ? (t >> 12) : 16 + ((t - 65536) >> 13); }
__device__ __forceinline__ int tok_pos(int t) { return t < 65536 ? (t & 4095) : ((t - 65536) & 8191); }
__device__ __forceinline__ float silu_f(float g) { return g * __builtin_amdgcn_rcpf(1.0f + __expf(-g)); }
__device__ __forceinline__ float lo_bf(unsigned w) { return __uint_as_float(w << 16); }
__device__ __forceinline__ float hi_bf(unsigned w) { return __uint_as_float(w & 0xffff0000u); }

namespace pg8 {
constexpr int BM = 256, BK = 64, HALF = 128, HTB = HALF * BK * 2, STAGE_BYTES = 8 * HTB, NXCD = 8, WGM = 8;
__device__ __forceinline__ int lds_byte(int r, int c) { const int st = (r >> 4) * 2 + (c >> 5), rr = r & 15, cc = c & 31, ob = rr * 64 + cc * 2; return st * 1024 + (ob ^ (((ob >> 9) & 1) << 5)); }
__device__ __forceinline__ void stage_rc(int b, int& R, int& C) { const int st = b / 1024, sb = b % 1024, swz = sb ^ (((sb >> 9) & 1) << 5); R = (st >> 1) * 16 + swz / 64; C = (st & 1) * 32 + (swz % 64) / 2; }
__device__ __forceinline__ int perm32(int rho) { const int n = rho >> 4, i = rho & 15; return 8 * (i >> 2) + 4 * n + (i & 3); }
struct Unit { int pm, pn; };
struct Gemm { const bf16_t* A; const bf16_t* Bt; int M, N, K, lda, ldb; };
struct StaticOrder {
    int nM, nN, nwg, G, c;
    __device__ void init(int M, int N, int G_, int c_) { nM = M / BM; nN = N / BM; nwg = nM * nN; G = G_; c = c_; }
    __device__ bool next(int i, Unit& u) const {
        const long L = (long)i * G + c; if (L >= nwg) return false;
        int wgid = (int)L; { const int q = nwg / NXCD, r = nwg % NXCD, xcd = wgid % NXCD, off = wgid / NXCD; wgid = (xcd < r ? xcd * (q + 1) : r * (q + 1) + (xcd - r) * q) + off; }
        const int nig = WGM * nN, gid = wgid / nig, fm = gid * WGM, gsz = (nM - fm) < WGM ? (nM - fm) : WGM;
        u.pm = fm + ((wgid % nig) % gsz); u.pn = (wgid % nig) / gsz; return true;
    }
};

template <class Epi>
__device__ __forceinline__ void gemm_phase(LAS unsigned char* lds, const Gemm g, const StaticOrder& S, const Epi& E) {
    const int tid = opaque_tid(), wid = __builtin_amdgcn_readfirstlane(tid >> 6), lane = tid & 63, wr = wid >> 2, wc = wid & 3, fr = lane & 15, fq = lane >> 4;
    const int K = g.K, nt = K / BK;
    unsigned voffA[2], voffB[2];
#pragma unroll
    for (int i = 0; i < 2; ++i) { int R, C; stage_rc(tid * 16 + i * 8192, R, C); const int Rb = Epi::PERM ? ((R & ~31) + perm32(R & 31)) : R;
        voffA[i] = (unsigned)(R * g.lda + C) * 2u; voffB[i] = (unsigned)(Rb * g.ldb + C) * 2u; }
    const size_t kstep = (size_t)(BK * 2);
    const size_t hstepA = (size_t)HALF * g.lda * 2, hstepB = (size_t)HALF * g.ldb * 2;
    const size_t tstepA = 2 * hstepA, tstepB = 2 * hstepB;
    const unsigned ldsw = (unsigned)wid * 1024u;
    const int aoff = lds_byte(wr * 64 + fr, fq * 8), boff = lds_byte(wc * 32 + fr, fq * 8);
#define PG8_SA(b, h) (((b) * 2 + (h)) * HTB)
#define PG8_SB(b, h) ((4 + (b) * 2 + (h)) * HTB)
#define PG8_STAGE(bufoff, gbase, voff) do { _Pragma("unroll") for (int _i = 0; _i < 2; ++_i) \
        __builtin_amdgcn_global_load_lds((const unsigned*)((const char*)(gbase) + (voff)[_i]), (LAS unsigned*)(lds + (bufoff) + ldsw + _i * 8192), 16, 0, 0); } while (0)
#define PG8_LDA(dst, b, h) do { _Pragma("unroll") for (int m = 0; m < 4; ++m) _Pragma("unroll") for (int k = 0; k < 2; ++k) dst[m][k] = *(const LAS bf16x8*)(lds + PG8_SA(b, h) + aoff + m * 2048 + k * 1024); } while (0)
#define PG8_LDB(dst, b, h) do { _Pragma("unroll") for (int n = 0; n < 2; ++n) _Pragma("unroll") for (int k = 0; k < 2; ++k) dst[n][k] = *(const LAS bf16x8*)(lds + PG8_SB(b, h) + boff + n * 2048 + k * 1024); } while (0)
#define PG8_MMA(ai, bj, At, Bt) do { __builtin_amdgcn_s_setprio(1); _Pragma("unroll") for (int m = 0; m < 4; ++m) _Pragma("unroll") for (int n = 0; n < 2; ++n) _Pragma("unroll") for (int k = 0; k < 2; ++k) \
        acc[ai][bj][m][n] = __builtin_amdgcn_mfma_f32_16x16x32_bf16(Bt[n][k], At[m][k], acc[ai][bj][m][n], 0, 0, 0); __builtin_amdgcn_s_setprio(0); } while (0)
#define PG8_WAIT_V(n) asm volatile("s_waitcnt vmcnt(" #n ")" ::: "memory")
#define PG8_WAIT_L(n) asm volatile("s_waitcnt lgkmcnt(" #n ")" ::: "memory")
#define PG8_BAR __builtin_amdgcn_s_barrier()
#define PG8_SCHED __builtin_amdgcn_sched_barrier(0)
    Unit cur, nxt; int ui = 0;
    if (!S.next(0, cur)) return;
    f32x4 acc[2][2][4][2];
#pragma unroll
    for (int a = 0; a < 2; ++a)
#pragma unroll
        for (int b = 0; b < 2; ++b)
#pragma unroll
            for (int m = 0; m < 4; ++m)
#pragma unroll
                for (int n = 0; n < 2; ++n) acc[a][b][m][n] = (f32x4){0.f, 0.f, 0.f, 0.f};
    bf16x8 At[4][2], B0[2][2], B1[2][2];
    const char* cA = (const char*)g.A + (size_t)cur.pm * tstepA; const char* cB = (const char*)g.Bt + (size_t)cur.pn * tstepB;
    PG8_STAGE(PG8_SB(0, 0), cB, voffB); PG8_STAGE(PG8_SA(0, 0), cA, voffA); PG8_STAGE(PG8_SB(0, 1), cB + hstepB, voffB); PG8_STAGE(PG8_SA(0, 1), cA + hstepA, voffA);
    if (wr == 1) PG8_BAR;
    PG8_WAIT_V(4); PG8_BAR;
    PG8_STAGE(PG8_SB(1, 0), cB + kstep, voffB); PG8_STAGE(PG8_SA(1, 0), cA + kstep, voffA); PG8_STAGE(PG8_SB(1, 1), cB + hstepB + kstep, voffB);
    PG8_WAIT_V(6); PG8_BAR;
    for (;;) {
        const bool has_next = S.next(ui + 1, nxt);
        const char* nA = has_next ? (const char*)g.A + (size_t)nxt.pm * tstepA : cA; const char* nB = has_next ? (const char*)g.Bt + (size_t)nxt.pn * tstepB : cB;
#pragma unroll 1
        for (int t = 0; t < nt; t += 2) {
            const bool last = (t == nt - 2);
            const char* a1 = cA + (size_t)(t + 1) * kstep;
            const char* a2 = last ? nA : cA + (size_t)(t + 2) * kstep; const char* b2 = last ? nB : cB + (size_t)(t + 2) * kstep;
            const char* a3 = a2 + kstep; const char* b3 = b2 + kstep;
            PG8_LDB(B0, 0, 0); PG8_SCHED; PG8_LDA(At, 0, 0); PG8_STAGE(PG8_SA(1, 1), a1 + hstepA, voffA);
            PG8_WAIT_L(8); PG8_BAR; PG8_WAIT_L(0); PG8_MMA(0, 0, At, B0); PG8_BAR; PG8_SCHED;
            PG8_LDB(B1, 0, 1); PG8_STAGE(PG8_SB(0, 0), b2, voffB);
            PG8_BAR; PG8_WAIT_L(0); PG8_MMA(0, 1, At, B1); PG8_BAR;
            PG8_LDA(At, 0, 1); PG8_STAGE(PG8_SA(0, 0), a2, voffA);
            PG8_BAR; PG8_WAIT_L(0); PG8_MMA(1, 0, At, B0); PG8_BAR; PG8_SCHED;
            PG8_STAGE(PG8_SB(0, 1), b2 + hstepB, voffB);
            PG8_WAIT_V(6); PG8_BAR; PG8_MMA(1, 1, At, B1); PG8_BAR;
            PG8_LDB(B0, 1, 0); PG8_SCHED; PG8_LDA(At, 1, 0); PG8_STAGE(PG8_SA(0, 1), a2 + hstepA, voffA);
            PG8_WAIT_L(8); PG8_BAR; PG8_WAIT_L(0); PG8_MMA(0, 0, At, B0); PG8_BAR; PG8_SCHED;
            PG8_LDB(B1, 1, 1); PG8_STAGE(PG8_SB(1, 0), b3, voffB);
            PG8_BAR; PG8_WAIT_L(0); PG8_MMA(0, 1, At, B1); PG8_BAR;
            PG8_LDA(At, 1, 1); PG8_STAGE(PG8_SA(1, 0), a3, voffA);
            PG8_BAR; PG8_WAIT_L(0); PG8_MMA(1, 0, At, B0); PG8_BAR; PG8_SCHED;
            PG8_STAGE(PG8_SB(1, 1), b3 + hstepB, voffB);
            PG8_WAIT_V(6); PG8_BAR; PG8_MMA(1, 1, At, B1); PG8_BAR;
        }
        E(acc, cur, wr, wc, fr, fq);
        if (!has_next) break;
#pragma unroll
        for (int a = 0; a < 2; ++a)
#pragma unroll
            for (int b = 0; b < 2; ++b)
#pragma unroll
                for (int m = 0; m < 4; ++m)
#pragma unroll
                    for (int n = 0; n < 2; ++n) acc[a][b][m][n] = (f32x4){0.f, 0.f, 0.f, 0.f};
        cur = nxt; cA = nA; cB = nB; ++ui;
    }
    PG8_WAIT_V(0);
    if (wr == 0) PG8_BAR;
    PG8_BAR;
#undef PG8_SA
#undef PG8_SB
#undef PG8_STAGE
#undef PG8_LDA
#undef PG8_LDB
#undef PG8_MMA
#undef PG8_WAIT_V
#undef PG8_WAIT_L
#undef PG8_BAR
#undef PG8_SCHED
}

__device__ __forceinline__ void rows_rstd(const float* ssq, int row0, int fq, float (&rsv)[8]) {
    f32x4 q[8];
#pragma unroll
    for (int r = 0; r < 8; ++r) q[r] = *(const f32x4*)(ssq + (size_t)(row0 + (r >> 2) * 128 + (r & 3) * 16) * 16 + 4 * fq);
#pragma unroll
    for (int r = 0; r < 8; ++r) { float a = (q[r][0] + q[r][1]) + (q[r][2] + q[r][3]); a += swz_xor<16>(a); a = sum_xor32(a); rsv[r] = rsqrtf(a * (1.0f / 1024.0f) + EPS); }
}
struct EpiGateUp {
    static constexpr bool PERM = false;
    bf16_t* O; const float* ssq; const float* tb;
    __device__ __forceinline__ void operator()(const f32x4 (&acc)[2][2][4][2], const Unit& u, int wr, int wc, int fr, int fq) const {
        const int row0 = u.pm * BM + wr * 64 + fr, col = u.pn * 128 + wc * 32 + fq * 8;
        const int b = tok_batch(u.pm * 256);
        const float* tbp = tb + (size_t)b * 5632 + u.pn * BM + wc * 32 + 4 * fq;
        const f32x4 tg0 = *(const f32x4*)(tbp), tu0 = *(const f32x4*)(tbp + 16), tg1 = *(const f32x4*)(tbp + HALF), tu1 = *(const f32x4*)(tbp + HALF + 16);
        float rsv[8]; rows_rstd(ssq, row0, fq, rsv);
#pragma unroll
        for (int ai = 0; ai < 2; ++ai)
#pragma unroll
            for (int m = 0; m < 4; ++m) {
                const int row = row0 + ai * HALF + m * 16;
                const float rs = rsv[ai * 4 + m];
                bf16_t* dst = O + (size_t)row * DFF + col;
                const f32x4 g0 = acc[ai][0][m][0] * rs + tg0, u0 = acc[ai][0][m][1] * rs + tu0, g1 = acc[ai][1][m][0] * rs + tg1, u1 = acc[ai][1][m][1] * rs + tu1;
                u32x4 w;
                w.x = cvt_pk_bf16(silu_f(g0[0]) * u0[0], silu_f(g0[1]) * u0[1]); w.y = cvt_pk_bf16(silu_f(g0[2]) * u0[2], silu_f(g0[3]) * u0[3]);
                w.z = cvt_pk_bf16(silu_f(g1[0]) * u1[0], silu_f(g1[1]) * u1[1]); w.w = cvt_pk_bf16(silu_f(g1[2]) * u1[2], silu_f(g1[3]) * u1[3]);
                asm volatile("global_store_dwordx4 %0, %1, off sc1\n\ts_nop 2" :: "v"(dst), "v"(w) : "memory");
            }
    }
};
__device__ __forceinline__ f32x4 safe_rcp4(f32x4 v) { f32x4 r; for (int e = 0; e < 4; ++e) r[e] = v[e] != 0.f ? 1.0f / v[e] : 0.f; return r; }
struct EpiResid {
    static constexpr bool PERM = false;
    const float* gate; float coef; int tile0;
    bf16_t* XS; const float* gprev; const float* scprev; const float* gnext; const float* scnext; float* ssq;
    __device__ __forceinline__ void operator()(f32x4 (&acc)[2][2][4][2], const Unit& u, int wr, int wc, int fr, int fq) const {
        int upm = u.pm, upn = u.pn; float cf = coef;
        typedef __attribute__((address_space(1))) float gf32; typedef __attribute__((address_space(1))) bf16_t gbf16;
        typedef __attribute__((address_space(1))) f32x4 gf32x4; typedef __attribute__((address_space(1))) u32x2 gu32x2;
        gbf16* XSp = (gbf16*)XS; gf32* sqp = (gf32*)ssq; const gf32* gtp = (const gf32*)gate; const gf32* gnp = (const gf32*)gnext; const gf32* scp = (const gf32*)scnext;
        const gf32* gpp = (const gf32*)gprev; const gf32* spp = (const gf32*)scprev;
        asm volatile("" : "+s"(upm), "+s"(upn), "+v"(cf), "+s"(XSp), "+s"(sqp), "+s"(gtp), "+s"(gnp), "+s"(scp), "+s"(gpp), "+s"(spp));
        const int row0 = upm * BM + wr * 64 + fr, col0 = upn * BM + wc * 32 + 4 * fq;
        const int b = tok_batch((tile0 + upm) * 256);
        f32x4 t0[2][2], t1[2][2], t2[2][2], inv[2][2], cs[2][2]; u32x2 xr[3][2][2];
#pragma unroll
        for (int bj = 0; bj < 2; ++bj)
#pragma unroll
            for (int n = 0; n < 2; ++n) { t0[bj][n] = *(const gf32x4*)(gtp + (size_t)b * MODW + col0 + bj * HALF + n * 16);
                t1[bj][n] = *(const gf32x4*)(gpp + col0 + bj * HALF + n * 16);
                t2[bj][n] = *(const gf32x4*)(spp + (size_t)b * MODW + col0 + bj * HALF + n * 16); }
#pragma unroll
        for (int q = 0; q < 2; ++q)
#pragma unroll
            for (int bj = 0; bj < 2; ++bj)
#pragma unroll
                for (int n = 0; n < 2; ++n) xr[q][bj][n] = *(const gu32x2*)(XSp + (size_t)(row0 + q * 16) * DM + col0 + bj * HALF + n * 16);
        __builtin_amdgcn_sched_barrier(0);
#pragma unroll
        for (int bj = 0; bj < 2; ++bj)
#pragma unroll
            for (int n = 0; n < 2; ++n) { const f32x4 g = t0[bj][n] * cf; inv[bj][n] = safe_rcp4(t1[bj][n] * (t2[bj][n] + 1.0f));
#pragma unroll
                for (int ai = 0; ai < 2; ++ai)
#pragma unroll
                    for (int m = 0; m < 4; ++m) acc[ai][bj][m][n] = acc[ai][bj][m][n] * g; }
        __builtin_amdgcn_sched_barrier(0);
#pragma unroll
        for (int bj = 0; bj < 2; ++bj)
#pragma unroll
            for (int n = 0; n < 2; ++n) { t0[bj][n] = *(const gf32x4*)(gnp + col0 + bj * HALF + n * 16); t1[bj][n] = *(const gf32x4*)(scp + (size_t)b * MODW + col0 + bj * HALF + n * 16); }
        __builtin_amdgcn_sched_barrier(0);
#pragma unroll
        for (int bj = 0; bj < 2; ++bj)
#pragma unroll
            for (int n = 0; n < 2; ++n) cs[bj][n] = t0[bj][n] * (t1[bj][n] + 1.0f);
#pragma unroll
        for (int r = 0; r < 8; ++r) {
            const int ai = r >> 2, m = r & 3;
            const int row = row0 + ai * HALF + m * 16; float ss = 0.f;
            if (r + 2 < 8) { const int rown = row0 + ((r + 2) >> 2) * HALF + ((r + 2) & 3) * 16;
#pragma unroll
                for (int bj = 0; bj < 2; ++bj)
#pragma unroll
                    for (int n = 0; n < 2; ++n) xr[(r + 2) % 3][bj][n] = *(const gu32x2*)(XSp + (size_t)rown * DM + col0 + bj * HALF + n * 16); }
#pragma unroll
            for (int bj = 0; bj < 2; ++bj)
#pragma unroll
                for (int n = 0; n < 2; ++n) { const u32x2 xo = xr[r % 3][bj][n];
                    const f32x4 xn = (f32x4){lo_bf(xo.x), hi_bf(xo.x), lo_bf(xo.y), hi_bf(xo.y)} * inv[bj][n] + acc[ai][bj][m][n];
                    ss += (xn[0] * xn[0] + xn[1] * xn[1]) + (xn[2] * xn[2] + xn[3] * xn[3]); const f32x4 y = xn * cs[bj][n];
                    u32x2 w; w.x = cvt_pk_bf16(y[0], y[1]); w.y = cvt_pk_bf16(y[2], y[3]); *(gu32x2*)(XSp + (size_t)row * DM + col0 + bj * HALF + n * 16) = w; }
            ss += swz_xor<16>(ss); ss = sum_xor32(ss); sqp[(size_t)row * 16 + upn * 4 + wc] = ss;
            __builtin_amdgcn_sched_barrier(0);
        }
    }
};
struct EpiResidLast {
    static constexpr bool PERM = false;
    const bf16_t* XS; const float* gprev; const float* scprev; const float* gate; float coef; float* lo; float* hi_;
    __device__ __forceinline__ void operator()(f32x4 (&acc)[2][2][4][2], const Unit& u, int wr, int wc, int fr, int fq) const {
        const int row0 = u.pm * BM + wr * 64 + fr, col0 = u.pn * BM + wc * 32 + 4 * fq;
        const int b = tok_batch(u.pm * 256);
        float* dst = (u.pm * BM < T_ALL / 2) ? lo : hi_;
        f32x4 gv[2][2], inv[2][2];
#pragma unroll
        for (int bj = 0; bj < 2; ++bj)
#pragma unroll
            for (int n = 0; n < 2; ++n) { gv[bj][n] = *(const f32x4*)(gate + (size_t)b * MODW + col0 + bj * HALF + n * 16) * coef;
                inv[bj][n] = safe_rcp4(*(const f32x4*)(gprev + col0 + bj * HALF + n * 16) * (*(const f32x4*)(scprev + (size_t)b * MODW + col0 + bj * HALF + n * 16) + 1.0f)); }
#pragma unroll
        for (int ai = 0; ai < 2; ++ai)
#pragma unroll
            for (int m = 0; m < 4; ++m) { const int row = row0 + ai * HALF + m * 16;
                u32x2 xo[2][2];
#pragma unroll
                for (int bj = 0; bj < 2; ++bj)
#pragma unroll
                    for (int n = 0; n < 2; ++n) xo[bj][n] = *(const u32x2*)(XS + (size_t)row * DM + col0 + bj * HALF + n * 16);
#pragma unroll
                for (int bj = 0; bj < 2; ++bj)
#pragma unroll
                    for (int n = 0; n < 2; ++n) { const u32x2 q = xo[bj][n];
                        *(f32x4*)(dst + (size_t)row * DM + col0 + bj * HALF + n * 16) = (f32x4){lo_bf(q.x), hi_bf(q.x), lo_bf(q.y), hi_bf(q.y)} * inv[bj][n] + gv[bj][n] * acc[ai][bj][m][n]; } }
    }
};
struct EpiBf16 {
    static constexpr bool PERM = true;
    bf16_t* O; int ldc;
    __device__ __forceinline__ void operator()(const f32x4 (&acc)[2][2][4][2], const Unit& u, int wr, int wc, int fr, int fq) const {
        const int row0 = u.pm * BM + wr * 64 + fr, col0 = u.pn * BM + wc * 32 + 8 * fq;
#pragma unroll
        for (int ai = 0; ai < 2; ++ai)
#pragma unroll
            for (int m = 0; m < 4; ++m) { bf16_t* rowp = O + (size_t)(row0 + ai * HALF + m * 16) * ldc + col0;
#pragma unroll
                for (int bj = 0; bj < 2; ++bj) { const f32x4 v0 = acc[ai][bj][m][0], v1 = acc[ai][bj][m][1];
                    u32x4 w; w.x = cvt_pk_bf16(v0[0], v0[1]); w.y = cvt_pk_bf16(v0[2], v0[3]); w.z = cvt_pk_bf16(v1[0], v1[1]); w.w = cvt_pk_bf16(v1[2], v1[3]);
                    *(u32x4*)(rowp + bj * HALF) = w; } }
    }
};
struct EpiBf16N {
    static constexpr bool PERM = true;
    bf16_t* O; int ldc; const float* ssq; const float* tb; int ldtb; int tile0;
    __device__ __forceinline__ void operator()(const f32x4 (&acc)[2][2][4][2], const Unit& u, int wr, int wc, int fr, int fq) const {
        const int row0 = u.pm * BM + wr * 64 + fr, col0 = u.pn * BM + wc * 32 + 8 * fq;
        const int b = tok_batch((tile0 + u.pm) * 256);
        const float* tbp = tb + (size_t)b * ldtb + col0;
        const f32x4 t00 = *(const f32x4*)(tbp), t01 = *(const f32x4*)(tbp + 4), t10 = *(const f32x4*)(tbp + HALF), t11 = *(const f32x4*)(tbp + HALF + 4);
        float rsv[8]; rows_rstd(ssq, row0, fq, rsv);
#pragma unroll
        for (int ai = 0; ai < 2; ++ai)
#pragma unroll
            for (int m = 0; m < 4; ++m) { const int row = row0 + ai * HALF + m * 16; bf16_t* rowp = O + (size_t)row * ldc + col0;
                const float rs = rsv[ai * 4 + m];
#pragma unroll
                for (int bj = 0; bj < 2; ++bj) { const f32x4 v0 = acc[ai][bj][m][0] * rs + (bj ? t10 : t00), v1 = acc[ai][bj][m][1] * rs + (bj ? t11 : t01);
                    u32x4 w; w.x = cvt_pk_bf16(v0[0], v0[1]); w.y = cvt_pk_bf16(v0[2], v0[3]); w.z = cvt_pk_bf16(v1[0], v1[1]); w.w = cvt_pk_bf16(v1[2], v1[3]);
                    *(u32x4*)(rowp + bj * HALF) = w; } }
    }
};
struct EpiKV {
    static constexpr bool PERM = true;
    bf16_t* Kn; bf16_t* V;
    __device__ __forceinline__ void operator()(const f32x4 (&acc)[2][2][4][2], const Unit& u, int wr, int wc, int fr, int fq) const {
        const int row0 = u.pm * BM + wr * 64 + fr, col0 = u.pn * 128 + wc * 32 + 8 * fq;
#pragma unroll
        for (int ai = 0; ai < 2; ++ai)
#pragma unroll
            for (int m = 0; m < 4; ++m) { const size_t off = (size_t)(row0 + ai * HALF + m * 16) * 1024 + col0;
#pragma unroll
                for (int bj = 0; bj < 2; ++bj) { const f32x4 v0 = acc[ai][bj][m][0], v1 = acc[ai][bj][m][1];
                    u32x4 w; w.x = cvt_pk_bf16(v0[0], v0[1]); w.y = cvt_pk_bf16(v0[2], v0[3]); w.z = cvt_pk_bf16(v1[0], v1[1]); w.w = cvt_pk_bf16(v1[2], v1[3]);
                    *(u32x4*)((bj ? V : Kn) + off) = w; } }
    }
};
}

template <class Epi>
__device__ __forceinline__ void run_gemm(LAS unsigned char* lds, const bf16_t* A, int lda, const bf16_t* Bt, int ldb, int M, int N, int K, const Epi& E) {
    pg8::Gemm g; g.A = A; g.Bt = Bt; g.M = M; g.N = N; g.K = K; g.lda = lda; g.ldb = ldb;
    pg8::StaticOrder S; S.init(M, N, (int)gridDim.x, opaque_bid());
    pg8::gemm_phase<Epi>(lds, g, S, E);
}

__device__ __forceinline__ void prep_mod(const Params& p, unsigned char* shm) {
    float* cact = (float*)shm;
    float* red = (float*)(shm + 81920);
    const int tid = opaque_tid(), bid = opaque_bid();
    if (bid >= 304) return;
    for (int idx = tid; idx < NSEQ * 1024; idx += 512) {
        const int b = idx >> 10, k = idx & 1023;
        const float c = b < 16 ? p.in[2][b * 1024 + k] : p.in[3][(b - 16) * 1024 + k];
        cact[k * NSEQ + b] = c / (1.0f + expf(-c));
    }
    __syncthreads();
    float* modbase = (float*)(p.ws + OFF_MOD);
    for (int it = bid; it < 304; it += gridDim.x) {
        const int mat = it < 288 ? it / 72 : 4, chunk = it < 288 ? it % 72 : it - 288, n0 = chunk * 128;
        const float* W = mat < 4 ? p.in[4] + (size_t)mat * 1024 * MODW : p.in[21];
        const float* bias = mat < 4 ? p.in[5] + mat * MODW : p.in[22];
        const int ldw = mat < 4 ? MODW : 2048;
        float* outp = mat < 4 ? modbase + (size_t)mat * NSEQ * MODW : modbase + 4ull * NSEQ * MODW;
        const int nl = tid & 127, ks = tid >> 7;
        float acc[NSEQ];
#pragma unroll
        for (int b = 0; b < NSEQ; ++b) acc[b] = 0.f;
        const float* wp = W + (size_t)(ks * 256) * ldw + n0 + nl;
#pragma unroll 4
        for (int k = 0; k < 256; ++k) {
            const float w = wp[(size_t)k * ldw];
            const f32x4* cv = (const f32x4*)(cact + (ks * 256 + k) * NSEQ);
#pragma unroll
            for (int q = 0; q < 5; ++q) { const f32x4 c4 = cv[q]; acc[q * 4 + 0] += c4[0] * w; acc[q * 4 + 1] += c4[1] * w; acc[q * 4 + 2] += c4[2] * w; acc[q * 4 + 3] += c4[3] * w; }
        }
#pragma unroll
        for (int b = 0; b < NSEQ; ++b) red[(ks * 128 + nl) * NSEQ + b] = acc[b];
        __syncthreads();
        for (int o = tid; o < 128 * NSEQ; o += 512) {
            const int b = o >> 7, n = o & 127;
            const float s = red[(0 * 128 + n) * NSEQ + b] + red[(1 * 128 + n) * NSEQ + b] + red[(2 * 128 + n) * NSEQ + b] + red[(3 * 128 + n) * NSEQ + b];
            outp[(size_t)b * ldw + n0 + n] = s + bias[n0 + n];
        }
        __syncthreads();
    }
}

__device__ __forceinline__ void prep_rope(const Params& p) {
    f32x2* tab = (f32x2*)(p.ws + OFF_ROPE);
    for (int i = opaque_bid() * 512 + opaque_tid(); i < 8192 * 32; i += gridDim.x * 512) {
        const int pos = i >> 5, j = i & 31;
        const float inv = 1.0f / powf(10000.0f, (float)(2 * j) / 64.0f);
        const float ang = (float)pos * inv;
        float s, c; sincosf(ang, &s, &c);
        tab[i] = (f32x2){c, s};
    }
}

__device__ __forceinline__ void prep_weights(const Params& p, unsigned char* shm) {
    float* tile = (float*)shm;
    const int tid = opaque_tid();
    bf16_t* Wb = (bf16_t*)(p.ws + OFF_W);
    constexpr int T_GU = 88 * 8, T_DN = 16 * 22, T_FFN = T_GU + T_DN, T_FFN_ALL = 8 * T_FFN;
    constexpr int T_GIN = 52 * 8, T_GOUT = 128, T_MIN = 8 * 8, T_UQ = 24 * 2, T_UKV = 32 * 2, T_MOUT = 128, T_MIX = T_GIN + T_GOUT + T_MIN + T_UQ + T_UKV + T_MOUT;
    constexpr int T_TOTAL = T_FFN_ALL + 2 * T_MIX;
    for (int idx = opaque_bid(); idx < T_TOTAL; idx += gridDim.x) {
        const float* src; const float* src2 = nullptr; int ldsrc, ksrc, nsrc, ldk, NT, mode = 0, loc; bf16_t* dst;
        if (idx < T_FFN_ALL) {
            const int lw = idx / T_FFN; loc = idx % T_FFN;
            if (loc < T_GU) { src = p.in[7] + (size_t)lw * 1024 * DFF; src2 = p.in[8] + (size_t)lw * 1024 * DFF; ldsrc = DFF; ksrc = 1024; nsrc = DFF; ldk = 1024; NT = 88; mode = 1; dst = Wb + (size_t)lw * W_FFN_STRIDE; }
            else { loc -= T_GU; src = p.in[9] + (size_t)lw * DFF * 1024; ldsrc = 1024; ksrc = DFF; nsrc = 1024; ldk = DFF; NT = 16; dst = Wb + (size_t)lw * W_FFN_STRIDE + SZ_GU; }
        } else {
            const int r = idx - T_FFN_ALL, j = r / T_MIX; loc = r % T_MIX;
            bf16_t* mb = Wb + W_FFN_TOTAL + (size_t)j * W_MIX_STRIDE;
            if (loc < T_GIN) { src = p.in[10] + (size_t)j * 1024 * 3104; ldsrc = 3104; ksrc = 1024; nsrc = 3104; ldk = 1024; NT = 52; dst = mb; }
            else if ((loc -= T_GIN) < T_GOUT) { src = p.in[14] + (size_t)j * 1024 * 1024; ldsrc = 1024; ksrc = 1024; nsrc = 1024; ldk = 1024; NT = 16; dst = mb + SZ_GIN; }
            else if ((loc -= T_GOUT) < T_MIN) { src = p.in[15] + (size_t)j * 1024 * 448; ldsrc = 448; ksrc = 1024; nsrc = 448; ldk = 1024; NT = 8; dst = mb + SZ_GIN + SZ_GOUT; }
            else if ((loc -= T_MIN) < T_UQ) { src = p.in[18] + (size_t)j * 256 * 1536; ldsrc = 1536; ksrc = 256; nsrc = 1536; ldk = 256; NT = 24; dst = mb + SZ_GIN + SZ_GOUT + SZ_MIN; }
            else if ((loc -= T_UQ) < T_UKV) { src = p.in[19] + (size_t)j * 128 * 2048; ldsrc = 2048; ksrc = 128; nsrc = 2048; ldk = 256; NT = 32; dst = mb + SZ_GIN + SZ_GOUT + SZ_MIN + SZ_UQ; }
            else { loc -= T_UKV; src = p.in[20] + (size_t)j * 1024 * 1024; ldsrc = 1024; ksrc = 1024; nsrc = 1024; ldk = 1024; NT = 16; dst = mb + SZ_GIN + SZ_GOUT + SZ_MIN + SZ_UQ + SZ_UKV; }
        }
        const int n0 = (loc % NT) * 64, k0 = (loc / NT) * 128;
        {
            const int j = tid & 63, kk = tid >> 6;
            int col = n0 + j; const float* sp = src;
            if (mode == 1) { const int nsel = n0 >= DFF ? 1 : 0; col = n0 - nsel * DFF + j; sp = nsel ? src2 : src; }
#pragma unroll
            for (int i = 0; i < 16; ++i) { const int k = k0 + kk + 8 * i;
                tile[(kk + 8 * i) * 65 + j] = (k < ksrc && col < nsrc) ? sp[(size_t)k * ldsrc + col] : 0.f; }
        }
        __syncthreads();
        {
            const int j = tid >> 3, kc = (tid & 7) * 8;
            int drow = n0 + j;
            if (mode == 1) { const int nsel = n0 >= DFF ? 1 : 0, c = n0 - nsel * DFF + j;
                drow = 256 * (c >> 7) + 128 * ((c >> 2) & 1) + 32 * ((c >> 5) & 3) + 16 * nsel + 4 * ((c >> 3) & 3) + (c & 3); }
#pragma unroll
            for (int h = 0; h < 2; ++h) {
                float v[8];
#pragma unroll
                for (int e = 0; e < 8; ++e) v[e] = tile[(h * 64 + kc + e) * 65 + j];
                u32x4 w; w.x = cvt_pk_bf16(v[0], v[1]); w.y = cvt_pk_bf16(v[2], v[3]); w.z = cvt_pk_bf16(v[4], v[5]); w.w = cvt_pk_bf16(v[6], v[7]);
                *(u32x4*)(dst + (size_t)drow * ldk + k0 + h * 64 + kc) = w;
            }
        }
        __syncthreads();
    }
}

__device__ __forceinline__ void phase_tb(const Params& p, unsigned char* shm) {
    float* sh = (float*)shm;
    const int tid = opaque_tid(), wid = tid >> 6, lane = tid & 63;
    const bf16_t* Wb = (const bf16_t*)(p.ws + OFF_W);
    const float* modb = (const float*)(p.ws + OFF_MOD);
    float* tball = (float*)(p.ws + OFF_TB);
    constexpr int U_FFN = 88, U_PROJ = 52, U_CIN = 8, U_TOTAL = 8 * U_FFN + 2 * U_PROJ + 2 * U_CIN;
    int loaded = -1;
    for (int un = opaque_bid(); un < U_TOTAL; un += gridDim.x) {
        int tab, chunk, N; const bf16_t* W; const float* shift; float* out;
        if (un < 8 * U_FFN) { tab = un / U_FFN; chunk = un % U_FFN; N = 5632; const int l = tab >> 1, w = tab & 1;
            W = Wb + (size_t)tab * W_FFN_STRIDE; shift = modb + (size_t)l * NSEQ * MODW + (w ? 6 : 0) * 1024; out = tball + (size_t)tab * TB_FFN_SZ; }
        else if (un < 8 * U_FFN + 2 * U_PROJ) { const int r = un - 8 * U_FFN, j = r / U_PROJ; chunk = r % U_PROJ; tab = 8 + j; N = 3328;
            W = Wb + W_FFN_TOTAL + (size_t)j * W_MIX_STRIDE; shift = modb + (size_t)(2 * j) * NSEQ * MODW + 3 * 1024; out = tball + 8 * TB_FFN_SZ + (size_t)j * TB_PROJ_SZ; }
        else { const int r = un - 8 * U_FFN - 2 * U_PROJ, j = r / U_CIN; chunk = r % U_CIN; tab = 10 + j; N = 512;
            W = Wb + W_FFN_TOTAL + (size_t)j * W_MIX_STRIDE + SZ_GIN + SZ_GOUT; shift = modb + (size_t)(2 * j + 1) * NSEQ * MODW + 3 * 1024; out = tball + 8 * TB_FFN_SZ + 2 * TB_PROJ_SZ + (size_t)j * TB_CIN_SZ; }
        if (tab != loaded) {
            __syncthreads();
            for (int i = tid; i < NSEQ * 1024; i += 512) sh[i] = shift[(size_t)(i >> 10) * MODW + (i & 1023)];
            __syncthreads();
            loaded = tab;
        }
#pragma unroll 1
        for (int rr = 0; rr < 8; ++rr) {
            const int n = chunk * 64 + wid * 8 + rr;
            const u32x4 w0 = *(const u32x4*)(W + (size_t)n * 1024 + lane * 16), w1 = *(const u32x4*)(W + (size_t)n * 1024 + lane * 16 + 8);
            float wv[16];
#pragma unroll
            for (int q = 0; q < 4; ++q) { wv[2 * q] = lo_bf(w0[q]); wv[2 * q + 1] = hi_bf(w0[q]); wv[8 + 2 * q] = lo_bf(w1[q]); wv[8 + 2 * q + 1] = hi_bf(w1[q]); }
            float mine = 0.f;
#pragma unroll 2
            for (int bb = 0; bb < NSEQ; ++bb) {
                const f32x4* sp = (const f32x4*)(sh + bb * 1024 + lane * 16);
                float a = 0.f;
#pragma unroll
                for (int q = 0; q < 4; ++q) { const f32x4 s4 = sp[q]; a += s4[0] * wv[4 * q] + s4[1] * wv[4 * q + 1] + s4[2] * wv[4 * q + 2] + s4[3] * wv[4 * q + 3]; }
                a = wave_sum(a);
                mine = (lane == bb) ? a : mine;
            }
            if (lane < NSEQ) out[(size_t)lane * N + n] = mine;
        }
    }
}

__device__ __forceinline__ void phase_prenorm(const Params& p) {
    const int tid = opaque_tid(), wid = tid >> 6, lane = tid & 63;
    const float* g = p.in[6]; const float* scale = (const float*)(p.ws + OFF_MOD) + 1024;
    bf16_t* XS = (bf16_t*)p.out; float* ssq = (float*)(p.ws + OFF_SSQ);
    for (int row = opaque_bid() * 8 + wid; row < T_ALL; row += gridDim.x * 8) {
        const int b = tok_batch(row);
        const float* xr = row < 65536 ? p.in[0] + (size_t)row * DM : p.in[1] + (size_t)(row - 65536) * DM;
        f32x4 v[4]; float ss = 0.f;
#pragma unroll
        for (int j = 0; j < 4; ++j) { v[j] = *(const f32x4*)(xr + j * 256 + lane * 4); ss += v[j][0] * v[j][0] + v[j][1] * v[j][1] + v[j][2] * v[j][2] + v[j][3] * v[j][3]; }
        ss = wave_sum(ss);
        if (lane < 16) ssq[(size_t)row * 16 + lane] = lane == 0 ? ss : 0.f;
#pragma unroll
        for (int j = 0; j < 4; ++j) {
            const int c = j * 256 + lane * 4;
            const f32x4 gg = *(const f32x4*)(g + c), sc = *(const f32x4*)(scale + (size_t)b * MODW + c);
            const f32x4 y = v[j] * gg * (sc + 1.0f);
            u32x2 w; w.x = cvt_pk_bf16(y[0], y[1]); w.y = cvt_pk_bf16(y[2], y[3]); *(u32x2*)(XS + (size_t)row * DM + c) = w;
        }
    }
}

__device__ __forceinline__ void phase_final(const float* xlo, float* out, const float* g, const float* shift, const float* scale, int ldmod) {
    const int tid = opaque_tid(), wid = tid >> 6, lane = tid & 63;
    for (int row = opaque_bid() * 8 + wid; row < T_ALL; row += gridDim.x * 8) {
        const int b = tok_batch(row);
        const float* xr = (row < T_ALL / 2 ? xlo : (const float*)out) + (size_t)row * DM;
        f32x4 v[4]; float ss = 0.f;
#pragma unroll
        for (int j = 0; j < 4; ++j) { v[j] = *(const f32x4*)(xr + j * 256 + lane * 4); ss += v[j][0] * v[j][0] + v[j][1] * v[j][1] + v[j][2] * v[j][2] + v[j][3] * v[j][3]; }
        ss = wave_sum(ss);
        const float rstd = rsqrtf(ss * (1.0f / 1024.0f) + EPS);
#pragma unroll
        for (int j = 0; j < 4; ++j) {
            const int c = j * 256 + lane * 4;
            const f32x4 gg = *(const f32x4*)(g + c), sh = *(const f32x4*)(shift + (size_t)b * ldmod + c), sc = *(const f32x4*)(scale + (size_t)b * ldmod + c);
            f32x4 y;
#pragma unroll
            for (int e = 0; e < 4; ++e) y[e] = (v[j][e] * rstd * gg[e]) * (1.0f + sc[e]) + sh[e];
            *(f32x4*)(out + (size_t)row * DM + c) = y;
        }
    }
}

__device__ __forceinline__ void phase_gla_combine(const Params& p, int j, int grp) {
    const bf16_t* proj = (const bf16_t*)(p.ws + OFF_ACT + GLA_PROJ);
    const bf16_t* of = (const bf16_t*)(p.ws + OFF_ACT + GLA_OF);
    const bf16_t* ob = (const bf16_t*)(p.ws + OFF_ACT + GLA_OB);
    bf16_t* gated = (bf16_t*)(p.ws + OFF_ACT + GLA_OF);
    const float* gn = p.in[13] + j * 256;
    const int tid = opaque_tid(), wid = tid >> 6, lane = tid & 63;
    float gnv[16];
#pragma unroll
    for (int e = 0; e < 16; ++e) gnv[e] = gn[((lane & 15) * 16 + e)];
    for (int tok = opaque_bid() * 8 + wid; tok < TG; tok += gridDim.x * 8) {
        const u32x4 f0 = *(const u32x4*)(of + (size_t)tok * 1024 + lane * 16), f1 = *(const u32x4*)(of + (size_t)tok * 1024 + lane * 16 + 8);
        const u32x4 b0 = *(const u32x4*)(ob + (size_t)tok * 1024 + lane * 16), b1 = *(const u32x4*)(ob + (size_t)tok * 1024 + lane * 16 + 8);
        const u32x4 r0 = *(const u32x4*)(proj + (size_t)tok * 3328 + 2048 + lane * 16), r1 = *(const u32x4*)(proj + (size_t)tok * 3328 + 2048 + lane * 16 + 8);
        float o[16], r[16];
#pragma unroll
        for (int q = 0; q < 4; ++q) {
            o[2 * q] = lo_bf(f0[q]) + lo_bf(b0[q]); o[2 * q + 1] = hi_bf(f0[q]) + hi_bf(b0[q]);
            o[8 + 2 * q] = lo_bf(f1[q]) + lo_bf(b1[q]); o[8 + 2 * q + 1] = hi_bf(f1[q]) + hi_bf(b1[q]);
            r[2 * q] = lo_bf(r0[q]); r[2 * q + 1] = hi_bf(r0[q]); r[8 + 2 * q] = lo_bf(r1[q]); r[8 + 2 * q + 1] = hi_bf(r1[q]);
        }
        float ss = 0.f;
#pragma unroll
        for (int e = 0; e < 16; ++e) ss += o[e] * o[e];
        ss += swz_xor<1>(ss); ss += swz_xor<2>(ss); ss += swz_xor<4>(ss); ss += swz_xor<8>(ss);
        const float rstd = rsqrtf(ss * (1.0f / 256.0f) + EPS);
        float y[16];
#pragma unroll
        for (int e = 0; e < 16; ++e) y[e] = silu_f(r[e]) * (o[e] * rstd * gnv[e]);
        u32x4 w0, w1;
        w0.x = cvt_pk_bf16(y[0], y[1]); w0.y = cvt_pk_bf16(y[2], y[3]); w0.z = cvt_pk_bf16(y[4], y[5]); w0.w = cvt_pk_bf16(y[6], y[7]);
        w1.x = cvt_pk_bf16(y[8], y[9]); w1.y = cvt_pk_bf16(y[10], y[11]); w1.z = cvt_pk_bf16(y[12], y[13]); w1.w = cvt_pk_bf16(y[14], y[15]);
        *(u32x4*)(gated + (size_t)tok * 1024 + lane * 16) = w0; *(u32x4*)(gated + (size_t)tok * 1024 + lane * 16 + 8) = w1;
    }
}

__device__ __forceinline__ void phase_mla_normrope(const Params& p, int j, int grp) {
    const bf16_t* cin = (const bf16_t*)(p.ws + OFF_ACT + MLA_CIN);
    bf16_t* cn = (bf16_t*)(p.ws + OFF_ACT + MLA_CN);
    bf16_t* kr = (bf16_t*)(p.ws + OFF_ACT + MLA_KR);
    const f32x2* rope = (const f32x2*)(p.ws + OFF_ROPE);
    const float* gq = p.in[16] + j * 256; const float* gkv = p.in[17] + j * 128;
    const int tid = opaque_tid(), wid = tid >> 6, lane = tid & 63;
    const f32x4 gqv = *(const f32x4*)(gq + lane * 4); const f32x2 gkvv = *(const f32x2*)(gkv + lane * 2);
    for (int tok = opaque_bid() * 8 + wid; tok < TG; tok += gridDim.x * 8) {
        const bf16_t* row = cin + (size_t)tok * 512;
        const u32x2 cq = *(const u32x2*)(row + lane * 4);
        const unsigned ck = *(const unsigned*)(row + 256 + lane * 2);
        const float x = bf2f(row[384 + lane]);
        const float q0 = lo_bf(cq.x), q1 = hi_bf(cq.x), q2 = lo_bf(cq.y), q3 = hi_bf(cq.y), k0 = lo_bf(ck), k1 = hi_bf(ck);
        float ssq = q0 * q0 + q1 * q1 + q2 * q2 + q3 * q3, ssk = k0 * k0 + k1 * k1;
        ssq = wave_sum(ssq); ssk = wave_sum(ssk);
        const float rq = rsqrtf(ssq * (1.0f / 256.0f) + EPS), rk = rsqrtf(ssk * (1.0f / 128.0f) + EPS);
        u32x2 wq; wq.x = cvt_pk_bf16(q0 * rq * gqv[0], q1 * rq * gqv[1]); wq.y = cvt_pk_bf16(q2 * rq * gqv[2], q3 * rq * gqv[3]);
        *(u32x2*)(cn + (size_t)tok * 512 + lane * 4) = wq;
        *(unsigned*)(cn + (size_t)tok * 512 + 256 + lane * 2) = cvt_pk_bf16(k0 * rk * gkvv[0], k1 * rk * gkvv[1]);
        *(unsigned*)(cn + (size_t)tok * 512 + 384 + lane * 2) = 0u;
        const float other = get_xor32(x, lane >> 5);
        const int pos = tok_pos(grp * TG + tok);
        const f32x2 cs = rope[pos * 32 + (lane & 31)];
        const float y = lane < 32 ? (x * cs[0] - other * cs[1]) : (other * cs[1] + x * cs[0]);
        kr[(size_t)tok * 64 + lane] = f2bf(y);
    }
}

namespace att {
constexpr int DQK = 192, DV = 128, NW = 8, QBLK = 32, KVBLK = 64;
constexpr float SCALE = 0.07216878364870322f;
constexpr float THR = 8.f;
constexpr int LDQ = 1536, LDK = 1024, LDKR = 64, LDO = 1024;
constexpr int SHM_V = KVBLK * DV * 2, SHM_K = KVBLK * DQK * 2, SHM_ATTN = 3 * SHM_V + 3 * SHM_K + NW * 64 * 4;
static_assert(SHM_ATTN <= LDS_MAIN, "attention LDS");
#define KSWZ(row, colB) ((row) * 384 + ((colB) ^ ((((row) >> 1) & 7) << 4)))
#define SBAR() __builtin_amdgcn_sched_barrier(0)
__device__ __forceinline__ int crow(int r, int hi) { return (r & 3) + 8 * (r >> 2) + 4 * hi; }
__device__ __forceinline__ void partialSM(f32x16& p0, f32x16& p1, float& m_reg, float& mn, float& alpha) {
    constexpr float C = SCALE * 1.4426950408889634f;
    float pmax = p0[0];
#pragma unroll
    for (int r = 1; r < 16; ++r) pmax = fmaxf(pmax, p0[r]);
#pragma unroll
    for (int r = 0; r < 16; ++r) pmax = fmaxf(pmax, p1[r]);
    { auto rr = __builtin_amdgcn_permlane32_swap(__float_as_uint(pmax), __float_as_uint(pmax), false, false);
      pmax = fmaxf(__uint_as_float(rr[0]), __uint_as_float(rr[1])); }
    if (__builtin_expect(__all(pmax - m_reg <= THR / SCALE), 1)) { mn = m_reg; alpha = 1.f; }
    else { mn = fmaxf(m_reg, pmax); alpha = __builtin_amdgcn_exp2f((m_reg - mn) * C); m_reg = mn; }
    const float mnC = -mn * C;
#pragma unroll
    for (int r = 0; r < 16; ++r) p0[r] = fmaf(p0[r], C, mnC);
#pragma unroll
    for (int r = 0; r < 16; ++r) p1[r] = fmaf(p1[r], C, mnC);
#pragma unroll
    for (int r = 0; r < 16; ++r) p0[r] = __builtin_amdgcn_exp2f(p0[r]);
}
__device__ __forceinline__ void finishSM(f32x16& p0, f32x16& p1, float alpha, float& l_reg, bf16x8& pa0, bf16x8& pa1, bf16x8& pa2, bf16x8& pa3) {
#pragma unroll
    for (int r = 0; r < 16; ++r) p1[r] = __builtin_amdgcn_exp2f(p1[r]);
    float ps = 0;
#pragma unroll
    for (int r = 0; r < 16; ++r) ps += p0[r];
#pragma unroll
    for (int r = 0; r < 16; ++r) ps += p1[r];
    { auto rr = __builtin_amdgcn_permlane32_swap(__float_as_uint(ps), __float_as_uint(ps), false, false);
      ps = __uint_as_float(rr[0]) + __uint_as_float(rr[1]); }
    l_reg = l_reg * alpha + ps;
#define PK4(P, BASE, OUT) do { unsigned a0 = cvt_pk_bf16(P[BASE + 0], P[BASE + 1]), a1 = cvt_pk_bf16(P[BASE + 2], P[BASE + 3]);   \
    unsigned b0 = cvt_pk_bf16(P[BASE + 4], P[BASE + 5]), b1 = cvt_pk_bf16(P[BASE + 6], P[BASE + 7]);                              \
    auto r0 = __builtin_amdgcn_permlane32_swap(a0, b0, false, false); auto r1 = __builtin_amdgcn_permlane32_swap(a1, b1, false, false); \
    u32x4 w = {r0[0], r1[0], r0[1], r1[1]}; OUT = *reinterpret_cast<bf16x8*>(&w); } while (0)
    PK4(p0, 0, pa0); PK4(p0, 8, pa1); PK4(p1, 0, pa2); PK4(p1, 8, pa3);
#undef PK4
}
__device__ __forceinline__ void qkt(f32x16& p0, f32x16& p1, const char* Ks, const bf16x8* qr, int r32, int hi) {
    p0 = f32x16{}; p1 = f32x16{};
#pragma unroll
    for (int d0 = 0; d0 < 12; ++d0) { const int cb = (d0 * 16 + hi * 8) * 2;
        const bf16x8 b0 = *reinterpret_cast<const bf16x8*>(Ks + KSWZ(r32, cb));
        const bf16x8 b1 = *reinterpret_cast<const bf16x8*>(Ks + KSWZ(32 + r32, cb));
        p0 = __builtin_amdgcn_mfma_f32_32x32x16_bf16(b0, qr[d0], p0, 0, 0, 0);
        p1 = __builtin_amdgcn_mfma_f32_32x32x16_bf16(b1, qr[d0], p1, 0, 0, 0); }
}
__device__ __forceinline__ int v_st(int k, int c) { const int kk = (k & ~0xC) | ((k & 4) << 1) | ((k & 8) >> 1); return ((kk >> 3) * 4 + (c >> 5)) * 512 + ((kk & 7) * 32 + (c & 31)) * 2; }
__device__ __forceinline__ int v_rd_base(int lane) { return ((lane & 3) << 3) | (((lane >> 2) & 3) << 6) | (((lane >> 4) & 1) << 5) | (((lane >> 5) & 1) << 8); }
constexpr int v_rd_off(int d0, int ks, int half) { return d0 * 512 + ks * 4096 + half * 2048; }
template <int OFF> __device__ __forceinline__ s16x4 tr_read(int vb) {
    s16x4 r; asm volatile("ds_read_b64_tr_b16 %0, %1 offset:%2" : "=&v"(r) : "v"(vb), "i"(OFF) : "memory"); return r;
}
template <int D0> __device__ __forceinline__ void pv_one(f32x16& od, int vb, bf16x8 pa0, bf16x8 pa1, bf16x8 pa2, bf16x8 pa3) {
    const s16x4 l0 = tr_read<v_rd_off(D0, 0, 0)>(vb), h0 = tr_read<v_rd_off(D0, 0, 1)>(vb), l1 = tr_read<v_rd_off(D0, 1, 0)>(vb), h1 = tr_read<v_rd_off(D0, 1, 1)>(vb);
    const s16x4 l2 = tr_read<v_rd_off(D0, 2, 0)>(vb), h2 = tr_read<v_rd_off(D0, 2, 1)>(vb), l3 = tr_read<v_rd_off(D0, 3, 0)>(vb), h3 = tr_read<v_rd_off(D0, 3, 1)>(vb);
    asm volatile("s_waitcnt lgkmcnt(0)" ::: "memory"); SBAR();
#define PK(L, H) (bf16x8){L[0], L[1], L[2], L[3], H[0], H[1], H[2], H[3]}
    od = __builtin_amdgcn_mfma_f32_32x32x16_bf16(PK(l0, h0), pa0, od, 0, 0, 0);
    od = __builtin_amdgcn_mfma_f32_32x32x16_bf16(PK(l1, h1), pa1, od, 0, 0, 0);
    od = __builtin_amdgcn_mfma_f32_32x32x16_bf16(PK(l2, h2), pa2, od, 0, 0, 0);
    od = __builtin_amdgcn_mfma_f32_32x32x16_bf16(PK(l3, h3), pa3, od, 0, 0, 0);
#undef PK
}
__device__ __forceinline__ void pv_d0(f32x16* o, int vb, bf16x8 pa0, bf16x8 pa1, bf16x8 pa2, bf16x8 pa3) {
    pv_one<0>(o[0], vb, pa0, pa1, pa2, pa3); pv_one<1>(o[1], vb, pa0, pa1, pa2, pa3); pv_one<2>(o[2], vb, pa0, pa1, pa2, pa3); pv_one<3>(o[3], vb, pa0, pa1, pa2, pa3);
}

__device__ __forceinline__ void body(const bf16_t* __restrict__ Qb, const bf16_t* __restrict__ Kn, const bf16_t* __restrict__ Kr, const bf16_t* __restrict__ Vh,
                                     bf16_t* __restrict__ Ob, int seq, int pos0, const f32x2* __restrict__ rope, char* lds, LAS unsigned char* ldsl) {
    const int tid = opaque_tid(), wid = tid >> 6, lane = tid & 63, r32 = lane & 31, hi = lane >> 5;
    char* V_lds = lds; char* K_lds = lds + 3 * SHM_V;
    float* ws = (float*)(lds + 3 * SHM_V + 3 * SHM_K) + wid * 64; float* li_l = ws; float* al_l = ws + 32;
    float m_reg = -1e30f, l_reg = 0; f32x16 o[4] = {}; bf16x8 qr[12];
    const bf16_t* Qw = Qb + (size_t)(wid * QBLK + r32) * LDQ + hi * 8;
#pragma unroll
    for (int d0 = 0; d0 < 12; ++d0) qr[d0] = *reinterpret_cast<const bf16x8*>(Qw + d0 * 16);
    {
        const f32x2* rp = rope + (size_t)(pos0 + wid * QBLK + r32) * 32;
#pragma unroll
        for (int dd = 0; dd < 2; ++dd) {
            bf16x8 x1 = qr[8 + dd], x2 = qr[10 + dd];
#pragma unroll
            for (int e = 0; e < 8; ++e) {
                const f32x2 cs = rp[dd * 16 + hi * 8 + e];
                const float a = bf2f((bf16_t)x1[e]), b = bf2f((bf16_t)x2[e]);
                x1[e] = (short)f2bf(a * cs[0] - b * cs[1]); x2[e] = (short)f2bf(a * cs[1] + b * cs[0]);
            }
            qr[8 + dd] = x1; qr[10 + dd] = x2;
        }
    }
    const int vb0 = (int)(uintptr_t)V_lds + v_rd_base(lane);
    const unsigned wbase = (unsigned)__builtin_amdgcn_readfirstlane(wid) * 1024u;
    const bf16_t* ksrc[3]; int kstr[3]; const bf16_t* vsrc[2];
#pragma unroll
    for (int pc = 0; pc < 3; ++pc) { const int bb = pc * 8192 + tid * 16, row = bb / 384, cB = (bb % 384) ^ ((((row >> 1) & 7)) << 4);
        if (cB < 256) { ksrc[pc] = Kn + (size_t)row * LDK + (cB >> 1); kstr[pc] = LDK; } else { ksrc[pc] = Kr + (size_t)row * LDKR + ((cB - 256) >> 1); kstr[pc] = LDKR; } }
#pragma unroll
    for (int pc = 0; pc < 2; ++pc) { const int bb = pc * 8192 + tid * 16, sub = bb >> 9, within = (bb & 511) >> 1, kk = (sub >> 2) * 8 + (within >> 5), c = (sub & 3) * 32 + (within & 31);
        const int k = (kk & ~0xC) | ((kk & 4) << 1) | ((kk & 8) >> 1); vsrc[pc] = Vh + (size_t)k * LDK + c; }
#define KVDMA(b, k0) do { _Pragma("unroll") for (int _p = 0; _p < 3; ++_p) __builtin_amdgcn_global_load_lds((const unsigned*)(ksrc[_p] + (size_t)(k0) * kstr[_p]), \
        (LAS unsigned*)(ldsl + 3 * SHM_V + (b) * SHM_K + _p * 8192 + wbase), 16, 0, 0); \
    _Pragma("unroll") for (int _p = 0; _p < 2; ++_p) __builtin_amdgcn_global_load_lds((const unsigned*)(vsrc[_p] + (size_t)(k0) * LDK), \
        (LAS unsigned*)(ldsl + (b) * SHM_V + _p * 8192 + wbase), 16, 0, 0); } while (0)
#define RESC(a) do { if (__any((a) < 1.f)) { \
    _Pragma("unroll") for (int d = 0; d < 4; ++d) _Pragma("unroll") for (int r = 0; r < 16; ++r) o[d][r] *= (a); } } while (0)
    f32x16 pA0, pA1, pB0, pB1; float mnA, mnB, alA, alB; bf16x8 pa0, pa1, pa2, pa3; const int NT = seq / KVBLK;
    KVDMA(0, 0); KVDMA(1, KVBLK); asm volatile("s_waitcnt vmcnt(0)" ::: "memory"); __syncthreads();
    qkt(pA0, pA1, K_lds, qr, r32, hi); partialSM(pA0, pA1, m_reg, mnA, alA);
    int bp = 0, bc = 1, bn = 2;
    for (int j = 1; j + 1 < NT; j += 2) {
        KVDMA(bn, (j + 1) * KVBLK);
        SBAR(); qkt(pB0, pB1, K_lds + bc * SHM_K, qr, r32, hi);
        finishSM(pA0, pA1, alA, l_reg, pa0, pa1, pa2, pa3); SBAR();
        pv_d0(o, vb0 + bp * SHM_V, pa0, pa1, pa2, pa3); partialSM(pB0, pB1, m_reg, mnB, alB);
        RESC(alB);
        asm volatile("s_waitcnt vmcnt(0)" ::: "memory"); __syncthreads();
        { const int t = bp; bp = bc; bc = bn; bn = t; }
        if (j + 2 < NT) KVDMA(bn, (j + 2) * KVBLK);
        SBAR(); qkt(pA0, pA1, K_lds + bc * SHM_K, qr, r32, hi);
        finishSM(pB0, pB1, alB, l_reg, pa0, pa1, pa2, pa3); SBAR();
        pv_d0(o, vb0 + bp * SHM_V, pa0, pa1, pa2, pa3); partialSM(pA0, pA1, m_reg, mnA, alA);
        RESC(alA);
        asm volatile("s_waitcnt vmcnt(0)" ::: "memory"); __syncthreads();
        { const int t = bp; bp = bc; bc = bn; bn = t; }
    }
    SBAR(); qkt(pB0, pB1, K_lds + bc * SHM_K, qr, r32, hi);
    finishSM(pA0, pA1, alA, l_reg, pa0, pa1, pa2, pa3); SBAR();
    pv_d0(o, vb0 + bp * SHM_V, pa0, pa1, pa2, pa3); partialSM(pB0, pB1, m_reg, mnB, alB);
    RESC(alB);
    finishSM(pB0, pB1, alB, l_reg, pa0, pa1, pa2, pa3); SBAR();
    pv_d0(o, vb0 + bc * SHM_V, pa0, pa1, pa2, pa3);
    {
        const float rl = __builtin_amdgcn_rcpf(l_reg);
        bf16_t* Ow = Ob + (size_t)(wid * QBLK + r32) * LDO + 4 * hi;
#pragma unroll
        for (int d0 = 0; d0 < 4; ++d0)
#pragma unroll
            for (int g = 0; g < 4; ++g) { u32x2 w; w.x = cvt_pk_bf16(o[d0][4 * g] * rl, o[d0][4 * g + 1] * rl); w.y = cvt_pk_bf16(o[d0][4 * g + 2] * rl, o[d0][4 * g + 3] * rl);
                *(u32x2*)(Ow + d0 * 32 + 8 * g) = w; }
    }
#undef KVDMA
#undef RESC
}
}


namespace gla {
#define KSWZ0(row, colB) ((row) * 256 + ((colB) ^ (((row) & 7) << 4)))
constexpr int L_Q = 0, L_K = 16384, L_V = 32768, L_B = 49152, L_ST = 81920, L_TOT = 114688, L_DEC = 115712;
#define GPK(L, H) (bf16x8){L[0], L[1], L[2], L[3], H[0], H[1], H[2], H[3]}
#define LDS_BARRIER() do { asm volatile("s_waitcnt lgkmcnt(0)" ::: "memory"); __builtin_amdgcn_s_barrier(); asm volatile("" ::: "memory"); } while (0)
__device__ __forceinline__ void phase(const Params& p, int j, int grp, unsigned char* shm) {
    using att::crow; using att::v_st; using att::v_rd_base; using att::v_rd_off; using att::tr_read;
    char* lds = (char*)shm;
    const bf16_t* proj = (const bf16_t*)(p.ws + OFF_ACT + GLA_PROJ);
    bf16_t* of = (bf16_t*)(p.ws + OFF_ACT + GLA_OF);
    bf16_t* ob = (bf16_t*)(p.ws + OFF_ACT + GLA_OB);
    const float* wup_all = p.in[11] + (size_t)j * 2 * 16 * 512;
    const float* bg_all = p.in[12] + (size_t)j * 2 * 512;
    const int tid = opaque_tid(), wid = __builtin_amdgcn_readfirstlane(tid >> 6), lane = tid & 63, r32 = lane & 31, hi = lane >> 5;
    const int ib = wid & 1, wq = wid >> 1;
    const int sr = tid >> 4, sc = (tid & 15) * 8, vst0 = v_st(sr, sc), vst1 = v_st(32 + sr, sc);
    float* tot = (float*)(lds + L_TOT); float* decay = (float*)(lds + L_DEC); float* Bt = (float*)(lds + L_B);
    const int nseq = grp == 0 ? 12 : 8, items = nseq * 16;
    for (int it = opaque_bid(); it < items; it += gridDim.x) {
        const int sl = (nseq - 1) - it / 16, rem = it % 16, h = rem >> 2, dir = (rem >> 1) & 1, dvh = rem & 1;
        int start, len;
        if (grp == 0 || sl < 4) { start = sl * 4096; len = 4096; } else { start = 16384 + (sl - 4) * 8192; len = 8192; }
        const int dcol = 32 * wq + r32;
        bf16x8 wf;
#pragma unroll
        for (int e = 0; e < 8; ++e) wf[e] = (short)f2bf(wup_all[(size_t)(dir * 16 + 8 * hi + e) * 512 + h * 128 + dcol]);
        const float bias_d = bg_all[dir * 512 + h * 128 + dcol];
        for (int i = tid; i < 2048; i += 512) *(u32x4*)(lds + L_ST + i * 16) = (u32x4){0u, 0u, 0u, 0u};
        f32x16 S0 = {}, S1 = {};
        bf16_t* odst = (dir ? ob : of) + h * 256 + dvh * 128;
        const bf16_t* qsrc = proj + h * 128 + sc;
        const bf16_t* ksrc = proj + 512 + h * 128 + sc;
        const bf16_t* vsrc = proj + 1024 + h * 256 + dvh * 128 + sc;
        const bf16_t* asrc = proj + 3072 + dir * 16 + 8 * hi;
        bf16x8 rq0, rq1, rk0, rk1, rv0, rv1, ra;
#define GLA_TOK(step) (start + (dir ? (len - 1 - (step)) : (step)))
#define GLA_LOAD(c) do { const size_t ta = (size_t)GLA_TOK((c) * 64 + sr) * 3328, tb = (size_t)GLA_TOK((c) * 64 + 32 + sr) * 3328; \
        rq0 = *(const bf16x8*)(qsrc + ta); rq1 = *(const bf16x8*)(qsrc + tb); rk0 = *(const bf16x8*)(ksrc + ta); rk1 = *(const bf16x8*)(ksrc + tb); \
        rv0 = *(const bf16x8*)(vsrc + ta); rv1 = *(const bf16x8*)(vsrc + tb); ra = *(const bf16x8*)(asrc + (size_t)GLA_TOK((c) * 64 + 32 * ib + r32) * 3328); } while (0)
        GLA_LOAD(0);
        __syncthreads();
        const int nch = len / 64;
        for (int c = 0; c < nch; ++c) {
            *(bf16x8*)(lds + L_V + vst0) = rv0; *(bf16x8*)(lds + L_V + vst1) = rv1;
            const bf16x8 cq0 = rq0, cq1 = rq1, ck0 = rk0, ck1 = rk1, af = ra;
            if (c + 1 < nch) GLA_LOAD(c + 1);
            {
                f32x16 z;
#pragma unroll
                for (int r = 0; r < 16; ++r) z[r] = bias_d;
                z = __builtin_amdgcn_mfma_f32_32x32x16_bf16(af, wf, z, 0, 0, 0);
                float la[16], tg[4], ug[4];
#pragma unroll
                for (int r = 0; r < 16; ++r) { const float zz = z[r] * 1.4426950408889634f;
                    la[r] = (fminf(zz, 0.f) - __builtin_amdgcn_logf(1.0f + __builtin_amdgcn_exp2f(-fabsf(zz)))) * 0.0625f; }
#pragma unroll
                for (int g = 0; g < 4; ++g) { tg[g] = (la[4 * g] + la[4 * g + 1]) + (la[4 * g + 2] + la[4 * g + 3]); ug[g] = get_xor32(tg[g], hi); }
                float run0 = 0.f;
#pragma unroll
                for (int g = 0; g < 4; ++g) {
                    float run = run0 + (hi ? ug[g] : 0.f);
#pragma unroll
                    for (int e = 0; e < 4; ++e) { run += la[4 * g + e]; Bt[(32 * ib + 8 * g + 4 * hi + e) * 128 + dcol] = run; }
                    run0 += tg[g] + ug[g];
                }
                if (hi == 0) tot[ib * 128 + dcol] = run0;
            }
            LDS_BARRIER();
            {
                const f32x4 t0a = *(const f32x4*)(tot + sc), t0b = *(const f32x4*)(tot + sc + 4);
                const f32x4 b0a = *(const f32x4*)(Bt + sr * 128 + sc), b0b = *(const f32x4*)(Bt + sr * 128 + sc + 4);
                const f32x4 b1a = *(const f32x4*)(Bt + (32 + sr) * 128 + sc) + t0a, b1b = *(const f32x4*)(Bt + (32 + sr) * 128 + sc + 4) + t0b;
                if (tid < 128) decay[tid] = __builtin_amdgcn_exp2f(tot[tid] + tot[128 + tid]);
                u32x4 qo0, ko0, qo1, ko1;
#define GLA_CVT(QO, KO, CQ, CK, BA, BB) do { const u32x4 _q = *reinterpret_cast<const u32x4*>(&CQ), _k = *reinterpret_cast<const u32x4*>(&CK); \
        _Pragma("unroll") for (int _w = 0; _w < 4; ++_w) { const float _b0 = _w < 2 ? BA[2 * _w] : BB[2 * _w - 4], _b1 = _w < 2 ? BA[2 * _w + 1] : BB[2 * _w - 3]; \
            const float _e0 = __builtin_amdgcn_exp2f(_b0), _e1 = __builtin_amdgcn_exp2f(_b1), _n0 = __builtin_amdgcn_exp2f(-_b0), _n1 = __builtin_amdgcn_exp2f(-_b1); \
            QO[_w] = cvt_pk_bf16(lo_bf(_q[_w]) * 0.08838834764831845f * _e0, hi_bf(_q[_w]) * 0.08838834764831845f * _e1); \
            KO[_w] = cvt_pk_bf16(lo_bf(_k[_w]) * _n0, hi_bf(_k[_w]) * _n1); } } while (0)
                GLA_CVT(qo0, ko0, cq0, ck0, b0a, b0b);
                GLA_CVT(qo1, ko1, cq1, ck1, b1a, b1b);
#undef GLA_CVT
                *(u32x4*)(lds + L_Q + KSWZ0(sr, sc * 2)) = qo0; *(u32x4*)(lds + L_Q + KSWZ0(32 + sr, sc * 2)) = qo1;
                *(u32x4*)(lds + L_K + vst0) = ko0; *(u32x4*)(lds + L_K + vst1) = ko1;
            }
            LDS_BARRIER();
            {
                bf16x8 qf[8];
#pragma unroll
                for (int d0 = 0; d0 < 8; ++d0) qf[d0] = *(const bf16x8*)(lds + L_Q + KSWZ0(32 * ib + r32, (d0 * 16 + hi * 8) * 2));
                f32x16 p0 = {}, p1 = {};
#pragma unroll
                for (int d0 = 0; d0 < 8; ++d0) { const bf16x8 kf = *(const bf16x8*)(lds + L_K + v_st(r32, d0 * 16 + hi * 8));
                    p0 = __builtin_amdgcn_mfma_f32_32x32x16_bf16(kf, qf[d0], p0, 0, 0, 0); }
                if (ib) {
#pragma unroll
                    for (int d0 = 0; d0 < 8; ++d0) { const bf16x8 kf = *(const bf16x8*)(lds + L_K + v_st(32 + r32, d0 * 16 + hi * 8));
                        p1 = __builtin_amdgcn_mfma_f32_32x32x16_bf16(kf, qf[d0], p1, 0, 0, 0); }
                }
#pragma unroll
                for (int r = 0; r < 16; ++r) { const bool keep = crow(r, hi) <= r32;
                    if (ib == 0) p0[r] = keep ? p0[r] : 0.f; else p1[r] = keep ? p1[r] : 0.f; }
                bf16x8 pa0, pa1, pa2, pa3;
#define GPK4(P, BASE, OUT) do { unsigned a0 = cvt_pk_bf16(P[BASE + 0], P[BASE + 1]), a1 = cvt_pk_bf16(P[BASE + 2], P[BASE + 3]);   \
    unsigned b0 = cvt_pk_bf16(P[BASE + 4], P[BASE + 5]), b1 = cvt_pk_bf16(P[BASE + 6], P[BASE + 7]);                              \
    auto r0 = __builtin_amdgcn_permlane32_swap(a0, b0, false, false); auto r1 = __builtin_amdgcn_permlane32_swap(a1, b1, false, false); \
    u32x4 w = {r0[0], r1[0], r0[1], r1[1]}; OUT = *reinterpret_cast<bf16x8*>(&w); } while (0)
                GPK4(p0, 0, pa0); GPK4(p0, 8, pa1); GPK4(p1, 0, pa2); GPK4(p1, 8, pa3);
#undef GPK4
                f32x16 o = {};
#pragma unroll
                for (int d0 = 0; d0 < 8; ++d0) { const bf16x8 sf = *(const bf16x8*)(lds + L_ST + KSWZ0(32 * wq + r32, (d0 * 16 + hi * 8) * 2));
                    o = __builtin_amdgcn_mfma_f32_32x32x16_bf16(sf, qf[d0], o, 0, 0, 0); }
                {
                    const int vbase = (int)(uintptr_t)(lds + L_V) + v_rd_base(lane) + wq * 512;
                    const s16x4 l0 = tr_read<v_rd_off(0, 0, 0)>(vbase), h0 = tr_read<v_rd_off(0, 0, 1)>(vbase), l1 = tr_read<v_rd_off(0, 1, 0)>(vbase), h1 = tr_read<v_rd_off(0, 1, 1)>(vbase);
                    const s16x4 l2 = tr_read<v_rd_off(0, 2, 0)>(vbase), h2 = tr_read<v_rd_off(0, 2, 1)>(vbase), l3 = tr_read<v_rd_off(0, 3, 0)>(vbase), h3 = tr_read<v_rd_off(0, 3, 1)>(vbase);
                    asm volatile("s_waitcnt lgkmcnt(0)" ::: "memory"); __builtin_amdgcn_sched_barrier(0);
                    o = __builtin_amdgcn_mfma_f32_32x32x16_bf16(GPK(l0, h0), pa0, o, 0, 0, 0);
                    o = __builtin_amdgcn_mfma_f32_32x32x16_bf16(GPK(l1, h1), pa1, o, 0, 0, 0);
                    o = __builtin_amdgcn_mfma_f32_32x32x16_bf16(GPK(l2, h2), pa2, o, 0, 0, 0);
                    o = __builtin_amdgcn_mfma_f32_32x32x16_bf16(GPK(l3, h3), pa3, o, 0, 0, 0);
                }
                {
                    bf16_t* orow = odst + (size_t)GLA_TOK(c * 64 + 32 * ib + r32) * 1024 + 32 * wq + 4 * hi;
#pragma unroll
                    for (int g = 0; g < 4; ++g) { u32x2 w; w.x = cvt_pk_bf16(o[4 * g], o[4 * g + 1]); w.y = cvt_pk_bf16(o[4 * g + 2], o[4 * g + 3]); *(u32x2*)(orow + 8 * g) = w; }
                }
            }
            {
                const int kbase = (int)(uintptr_t)(lds + L_K) + v_rd_base(lane) + wq * 512;
                const int vb0 = (int)(uintptr_t)(lds + L_V) + v_rd_base(lane) + (2 * ib) * 512, vb1 = vb0 + 512;
                const s16x4 kl0 = tr_read<v_rd_off(0, 0, 0)>(kbase), kh0 = tr_read<v_rd_off(0, 0, 1)>(kbase), kl1 = tr_read<v_rd_off(0, 1, 0)>(kbase), kh1 = tr_read<v_rd_off(0, 1, 1)>(kbase);
                const s16x4 kl2 = tr_read<v_rd_off(0, 2, 0)>(kbase), kh2 = tr_read<v_rd_off(0, 2, 1)>(kbase), kl3 = tr_read<v_rd_off(0, 3, 0)>(kbase), kh3 = tr_read<v_rd_off(0, 3, 1)>(kbase);
                const s16x4 al0 = tr_read<v_rd_off(0, 0, 0)>(vb0), ah0 = tr_read<v_rd_off(0, 0, 1)>(vb0), al1 = tr_read<v_rd_off(0, 1, 0)>(vb0), ah1 = tr_read<v_rd_off(0, 1, 1)>(vb0);
                const s16x4 al2 = tr_read<v_rd_off(0, 2, 0)>(vb0), ah2 = tr_read<v_rd_off(0, 2, 1)>(vb0), al3 = tr_read<v_rd_off(0, 3, 0)>(vb0), ah3 = tr_read<v_rd_off(0, 3, 1)>(vb0);
                const s16x4 bl0 = tr_read<v_rd_off(0, 0, 0)>(vb1), bh0 = tr_read<v_rd_off(0, 0, 1)>(vb1), bl1 = tr_read<v_rd_off(0, 1, 0)>(vb1), bh1 = tr_read<v_rd_off(0, 1, 1)>(vb1);
                const s16x4 bl2 = tr_read<v_rd_off(0, 2, 0)>(vb1), bh2 = tr_read<v_rd_off(0, 2, 1)>(vb1), bl3 = tr_read<v_rd_off(0, 3, 0)>(vb1), bh3 = tr_read<v_rd_off(0, 3, 1)>(vb1);
                float dk[16];
#pragma unroll
                for (int r = 0; r < 16; ++r) dk[r] = decay[32 * wq + crow(r, hi)];
                asm volatile("s_waitcnt lgkmcnt(0)" ::: "memory"); __builtin_amdgcn_sched_barrier(0);
                S0 = __builtin_amdgcn_mfma_f32_32x32x16_bf16(GPK(kl0, kh0), GPK(al0, ah0), S0, 0, 0, 0);
                S1 = __builtin_amdgcn_mfma_f32_32x32x16_bf16(GPK(kl0, kh0), GPK(bl0, bh0), S1, 0, 0, 0);
                S0 = __builtin_amdgcn_mfma_f32_32x32x16_bf16(GPK(kl1, kh1), GPK(al1, ah1), S0, 0, 0, 0);
                S1 = __builtin_amdgcn_mfma_f32_32x32x16_bf16(GPK(kl1, kh1), GPK(bl1, bh1), S1, 0, 0, 0);
                S0 = __builtin_amdgcn_mfma_f32_32x32x16_bf16(GPK(kl2, kh2), GPK(al2, ah2), S0, 0, 0, 0);
                S1 = __builtin_amdgcn_mfma_f32_32x32x16_bf16(GPK(kl2, kh2), GPK(bl2, bh2), S1, 0, 0, 0);
                S0 = __builtin_amdgcn_mfma_f32_32x32x16_bf16(GPK(kl3, kh3), GPK(al3, ah3), S0, 0, 0, 0);
                S1 = __builtin_amdgcn_mfma_f32_32x32x16_bf16(GPK(kl3, kh3), GPK(bl3, bh3), S1, 0, 0, 0);
#pragma unroll
                for (int r = 0; r < 16; ++r) { S0[r] *= dk[r]; S1[r] *= dk[r]; }
            }
            LDS_BARRIER();
#pragma unroll
            for (int g = 0; g < 4; ++g) {
                const int d0 = 32 * wq + 8 * g + 4 * hi;
                u32x2 w0; w0.x = cvt_pk_bf16(S0[4 * g], S0[4 * g + 1]); w0.y = cvt_pk_bf16(S0[4 * g + 2], S0[4 * g + 3]);
                u32x2 w1; w1.x = cvt_pk_bf16(S1[4 * g], S1[4 * g + 1]); w1.y = cvt_pk_bf16(S1[4 * g + 2], S1[4 * g + 3]);
                *(u32x2*)(lds + L_ST + KSWZ0(64 * ib + r32, 2 * d0)) = w0;
                *(u32x2*)(lds + L_ST + KSWZ0(64 * ib + 32 + r32, 2 * d0)) = w1;
            }
        }
        __syncthreads();
#undef GLA_LOAD
#undef GLA_TOK
    }
}
}

__device__ __forceinline__ void phase_mla_attn(const Params& p, int grp, unsigned char* shm) {
    const bf16_t* Q = (const bf16_t*)(p.ws + OFF_ACT + MLA_Q);
    const bf16_t* Kn = (const bf16_t*)(p.ws + OFF_ACT + MLA_KN);
    const bf16_t* Kr = (const bf16_t*)(p.ws + OFF_ACT + MLA_KR);
    const bf16_t* V = (const bf16_t*)(p.ws + OFF_ACT + MLA_V);
    bf16_t* O = (bf16_t*)(p.ws + OFF_ACT + MLA_O);
    const f32x2* rope = (const f32x2*)(p.ws + OFF_ROPE);
    const int nb = gridDim.x, per = nb >> 3, bid = opaque_bid(), xcd = bid & 7, slot = bid >> 3;
    constexpr int ITEMS = 1536;
    for (int r = 0;; ++r) {
        const int vv = r * nb + xcd * per + slot;
        if (vv >= ITEMS) break;
        int start, len, h, qb;
        if (grp == 0) { const int sl = vv >> 7; h = (vv & 127) >> 4; qb = vv & 15; start = sl * 4096; len = 4096; }
        else if (vv < 1024) { const int sl = vv >> 8; h = (vv & 255) >> 5; qb = vv & 31; start = 16384 + sl * 8192; len = 8192; }
        else { const int v2 = vv - 1024, sl = v2 >> 7; h = (v2 & 127) >> 4; qb = v2 & 15; start = sl * 4096; len = 4096; }
        const size_t q0 = (size_t)(start + qb * 256);
        att::body(Q + q0 * 1536 + h * 192, Kn + (size_t)start * 1024 + h * 128, Kr + (size_t)start * 64, V + (size_t)start * 1024 + h * 128,
                  O + q0 * 1024 + h * 128, len, qb * 256, rope, (char*)shm, (LAS unsigned char*)shm);
        __syncthreads();
    }
}


#define XB_TMO      128
#define XB_XCNT(j)  (256  + 64 * (j))
#define XB_XSUB(j)  (1280 + 64 * (j))
#define XB_XGEN(j)  (2304 + 64 * (j))
#define XB_TOP      3328
#define XB_TOPGEN   3392
#define XCD_BAR_WORDS 3456
#define XB_SPIN_CAP (1u << 23)
__device__ __forceinline__ unsigned xb_ld(unsigned* p)              { return __hip_atomic_load(p, __ATOMIC_RELAXED, __HIP_MEMORY_SCOPE_AGENT); }
__device__ __forceinline__ unsigned xb_add(unsigned* p, unsigned v) { return __hip_atomic_fetch_add(p, v, __ATOMIC_RELAXED, __HIP_MEMORY_SCOPE_AGENT); }
__device__ __forceinline__ unsigned xb_xcc_id() { return (unsigned)__builtin_amdgcn_s_getreg((3 << 11) | 20) & 0xFu; }
#define XB_SPIN(cond, bar) do { unsigned _sp = 0; while (cond) { __builtin_amdgcn_s_sleep(1); \
    if ((++_sp & 255u) == 0u) { if (xb_ld(&(bar)[XB_TMO])) break; if (_sp > XB_SPIN_CAP) { atomicAdd(&(bar)[XB_TMO], 1u); break; } } } } while (0)
__device__ __forceinline__ void xcd_barrier_post(unsigned* bar) { if (opaque_tid() == 0) (void)xb_add(&bar[XB_XCNT(xb_xcc_id())], 1u); }
__device__ __forceinline__ void xcd_barrier_complete(unsigned* bar, unsigned x, unsigned& nloc, unsigned& nx) {
    const unsigned G = gridDim.x;
    unsigned sum, cnt, mine, sp = 0u;
    for (;;) {
        sum = 0u; cnt = 0u; mine = 0u;
#pragma unroll
        for (unsigned j = 0; j < 16; ++j) { const unsigned c = xb_ld(&bar[XB_XCNT(j)]); sum += c; cnt += (c > 0u) ? 1u : 0u; mine = (j == x) ? c : mine; }
        if (sum == G) break;
        __builtin_amdgcn_s_sleep(1);
        if ((++sp & 255u) == 0u) { if (xb_ld(&bar[XB_TMO])) break; if (sp > XB_SPIN_CAP) { atomicAdd(&bar[XB_TMO], 1u); break; } }
    }
    nloc = mine > 0u ? mine : 1u; nx = cnt > 0u ? cnt : 1u;
}
__device__ __forceinline__ void xcd_barrier(unsigned* bar, volatile LAS unsigned* st) {
    asm volatile("s_waitcnt vmcnt(0)" ::: "memory");
    __syncthreads();
    if (opaque_tid() == 0) {
        const unsigned x = xb_xcc_id();
        __builtin_amdgcn_s_waitcnt(0);
        unsigned nloc = st[0], nx = st[1];
        if (nloc == 0u) { xcd_barrier_complete(bar, x, nloc, nx); st[0] = nloc; st[1] = nx; }
        const unsigned old = xb_add(&bar[XB_XSUB(x)], 1u);
        const unsigned gen = old / nloc;
        if (old + 1u == (gen + 1u) * nloc) {
            __builtin_amdgcn_fence(__ATOMIC_RELEASE, "agent");
            asm volatile("s_waitcnt vmcnt(0)" ::: "memory");
            const unsigned og = xb_add(&bar[XB_TOP], 1u);
            const unsigned tg = og / nx;
            if (og + 1u == (tg + 1u) * nx) xb_add(&bar[XB_TOPGEN], 1u);
            else XB_SPIN(xb_ld(&bar[XB_TOPGEN]) == tg, bar);
            __builtin_amdgcn_fence(__ATOMIC_ACQUIRE, "agent");
            xb_add(&bar[XB_XGEN(x)], 1u);
            asm volatile("s_waitcnt vmcnt(0)" ::: "memory");
        } else {
            XB_SPIN(xb_ld(&bar[XB_XGEN(x)]) == gen, bar);
            __builtin_amdgcn_fence(__ATOMIC_ACQUIRE, "agent");
            asm volatile("s_waitcnt vmcnt(0)" ::: "memory");
        }
    }
    __syncthreads();
}

#ifndef PH_MASK
#define PH_MASK 0xFFFFFF
#endif
#define PH(bit) if constexpr ((PH_MASK >> (bit)) & 1)
#ifndef PROBE_DBL
#define PROBE_DBL 0
#endif
#define GSYNC() do { xcd_barrier(xbar, xst); if constexpr ((PROBE_DBL >> 4) & 1) xcd_barrier(xbar, xst); } while (0)
#define DBL(bit) for (int _rep = 0; _rep < (((PROBE_DBL >> (bit)) & 1) ? 2 : 1); ++_rep)
__global__ __launch_bounds__(512, 2) void mega_kernel(Params p) {
    extern __shared__ __attribute__((aligned(16))) unsigned char shm[];
    cg::grid_group grid = cg::this_grid();
    LAS unsigned char* lds = (LAS unsigned char*)shm;
    bf16_t* Wb = (bf16_t*)(p.ws + OFF_W);
    const float* modb = (const float*)(p.ws + OFF_MOD);
    bf16_t* Hb = (bf16_t*)p.out;
    bf16_t* ACT = (bf16_t*)(p.ws + OFF_ACT);
    float* XF = (float*)(p.ws + OFF_H);
    unsigned* xbar = (unsigned*)(p.ws + OFF_BAR);
    volatile LAS unsigned* xst = (volatile LAS unsigned*)(lds + LDS_MAIN);
    if (opaque_tid() == 0) { xst[0] = 0u; xst[1] = 0u; }
    __syncthreads();
    xcd_barrier_post(xbar);

    DBL(5) {
    PH(0) prep_mod(p, shm);
    __syncthreads();
    PH(1) prep_rope(p);
    PH(2) prep_weights(p, shm);
    grid.sync();
    phase_tb(p, shm);
    phase_prenorm(p);
    GSYNC();
    }

    float* ssqb = (float*)(p.ws + OFF_SSQ);
    const float* tball = (const float*)(p.ws + OFF_TB);
#pragma unroll 1
    for (int l = 0; l < 4; ++l) {
        const float* modl = modb + (size_t)l * NSEQ * MODW;
        const int mj = l >> 1;
        const bf16_t* wmix = Wb + W_FFN_TOTAL + (size_t)mj * W_MIX_STRIDE;
#pragma unroll 1
        for (int w = 0; w < 2; ++w) {
            const int inst = 3 * l + (w ? 2 : 0), mi = w ? 6 : 0;
            float* ssq_cur = ssqb + (size_t)(inst & 1) * T_ALL * 16; float* ssq_nxt = ssqb + (size_t)((inst + 1) & 1) * T_ALL * 16;
            const bf16_t* wgu = Wb + (size_t)(l * 2 + w) * W_FFN_STRIDE;
            DBL(1) PH(5) { pg8::EpiGateUp E; E.O = ACT; E.ssq = ssq_cur; E.tb = tball + (size_t)(l * 2 + w) * TB_FFN_SZ; run_gemm(lds, Hb, 1024, wgu, 1024, T_ALL, 5632, 1024, E); }
            GSYNC();
            {
                const bool last = (l == 3 && w == 1);
                const int nl = w ? l + 1 : l;
                const float* gprev = p.in[6] + (size_t)(l * 3 + (w ? 2 : 0)) * 1024; const float* scprev = modl + (mi + 1) * 1024;
                if (last) { pg8::EpiResidLast E; E.XS = Hb; E.gprev = gprev; E.scprev = scprev; E.gate = modl + (mi + 2) * 1024; E.coef = 0.5f; E.lo = XF; E.hi_ = p.out;
                    run_gemm(lds, ACT, DFF, wgu + SZ_GU, DFF, T_ALL, 1024, DFF, E); }
                else { pg8::EpiResid E; E.gate = modl + (mi + 2) * 1024; E.coef = 0.5f; E.tile0 = 0; E.gprev = gprev; E.scprev = scprev;
                    E.XS = Hb; E.gnext = p.in[6] + (size_t)(nl * 3 + (w ? 0 : 1)) * 1024;
                    E.scnext = modb + (size_t)nl * NSEQ * MODW + (w ? 1 : 4) * 1024; E.ssq = ssq_nxt;
                    PH(6) run_gemm(lds, ACT, DFF, wgu + SZ_GU, DFF, T_ALL, 1024, DFF, E); }
            }
            GSYNC();
            if (w == 0) {
                float* ssq_m = ssq_nxt;
                float* ssq_f2 = ssq_cur;
#pragma unroll 1
                for (int grp = 0; grp < 2; ++grp) {
                    const bf16_t* hg = Hb + (size_t)grp * TG * 1024;
                    const int t0 = grp * (TG / 256);
                    if ((l & 1) == 0) {
                        PH(7) { pg8::EpiBf16N E; E.O = (bf16_t*)(p.ws + OFF_ACT + GLA_PROJ); E.ldc = 3328; E.ssq = ssq_m + (size_t)grp * TG * 16; E.tb = tball + 8 * TB_FFN_SZ + (size_t)mj * TB_PROJ_SZ; E.ldtb = 3328; E.tile0 = t0;
                            run_gemm(lds, hg, 1024, wmix, 1024, TG, 3328, 1024, E); }
                        GSYNC();
                        DBL(2) PH(8) gla::phase(p, mj, grp, shm);
                        GSYNC();
                        PH(9) phase_gla_combine(p, mj, grp);
                        GSYNC();
                        PH(13) { pg8::EpiResid E; E.gate = modl + 5 * 1024; E.coef = 1.0f; E.tile0 = t0; E.gprev = p.in[6] + (size_t)(l * 3 + 1) * 1024; E.scprev = modl + 4 * 1024;
                          E.XS = Hb + (size_t)grp * TG * 1024; E.gnext = p.in[6] + (size_t)(l * 3 + 2) * 1024; E.scnext = modl + 7 * 1024; E.ssq = ssq_f2 + (size_t)grp * TG * 16;
                          run_gemm(lds, (const bf16_t*)(p.ws + OFF_ACT + GLA_OF), 1024, wmix + SZ_GIN, 1024, TG, 1024, 1024, E); }
                        GSYNC();
                    } else {
                        const bf16_t* w_min = wmix + SZ_GIN + SZ_GOUT; const bf16_t* w_uq = w_min + SZ_MIN; const bf16_t* w_ukv = w_uq + SZ_UQ; const bf16_t* w_mout = w_ukv + SZ_UKV;
                        PH(14) { pg8::EpiBf16N E; E.O = (bf16_t*)(p.ws + OFF_ACT + MLA_CIN); E.ldc = 512; E.ssq = ssq_m + (size_t)grp * TG * 16; E.tb = tball + 8 * TB_FFN_SZ + 2 * TB_PROJ_SZ + (size_t)mj * TB_CIN_SZ; E.ldtb = 512; E.tile0 = t0;
                            run_gemm(lds, hg, 1024, w_min, 1024, TG, 512, 1024, E); }
                        GSYNC();
                        PH(10) phase_mla_normrope(p, mj, grp);
                        GSYNC();
                        const bf16_t* cn = (const bf16_t*)(p.ws + OFF_ACT + MLA_CN);
                        PH(15) { pg8::EpiBf16 E; E.O = (bf16_t*)(p.ws + OFF_ACT + MLA_Q); E.ldc = 1536; run_gemm(lds, cn, 512, w_uq, 256, TG, 1536, 256, E); }
                        PH(12) { pg8::EpiKV E; E.Kn = (bf16_t*)(p.ws + OFF_ACT + MLA_KN); E.V = (bf16_t*)(p.ws + OFF_ACT + MLA_V); run_gemm(lds, cn + 256, 512, w_ukv, 256, TG, 2048, 256, E); }
                        GSYNC();
                        DBL(0) PH(11) phase_mla_attn(p, grp, shm);
                        GSYNC();
                        PH(16) { pg8::EpiResid E; E.gate = modl + 5 * 1024; E.coef = 1.0f; E.tile0 = t0; E.gprev = p.in[6] + (size_t)(l * 3 + 1) * 1024; E.scprev = modl + 4 * 1024;
                          E.XS = Hb + (size_t)grp * TG * 1024; E.gnext = p.in[6] + (size_t)(l * 3 + 2) * 1024; E.scnext = modl + 7 * 1024; E.ssq = ssq_f2 + (size_t)grp * TG * 16;
                          run_gemm(lds, (const bf16_t*)(p.ws + OFF_ACT + MLA_O), 1024, w_mout, 1024, TG, 1024, 1024, E); }
                        GSYNC();
                    }
                }
            }
        }
    }
    const float* fin = modb + 4ull * NSEQ * MODW;
    phase_final(XF, p.out, p.in[23], fin, fin + 1024, 2048);
}

extern "C" void kernel_launch(void* const* d_in, const int* in_sizes, int n_in, void* d_out, int out_size, void* d_ws, size_t ws_size, hipStream_t stream) {
    static int grid_blocks = 0;
    if (!grid_blocks) {
        if (n_in != 24 || (size_t)out_size != (size_t)T_ALL * 1024 || ws_size < WS_NEED) {
            fprintf(stderr, "kernel_launch: unexpected shapes: n_in %d out %d ws %zu (need %zu)\n", n_in, out_size, ws_size, (size_t)WS_NEED);
            return;
        }
        if (hipFuncSetAttribute((const void*)mega_kernel, hipFuncAttributeMaxDynamicSharedMemorySize, LDS_BYTES) != hipSuccess) { fprintf(stderr, "kernel_launch: LDS attribute failed\n"); return; }
        int dev = 0, cus = 0, per_cu = 0;
        hipGetDevice(&dev);
        hipDeviceGetAttribute(&cus, hipDeviceAttributeMultiprocessorCount, dev);
        hipOccupancyMaxActiveBlocksPerMultiprocessor(&per_cu, mega_kernel, 512, LDS_BYTES);
        if (per_cu < 1) { fprintf(stderr, "kernel_launch: occupancy 0\n"); return; }
        grid_blocks = cus;
    }
    Params p{};
    for (int i = 0; i < 24; ++i) p.in[i] = (const float*)d_in[i];
    p.out = (float*)d_out; p.ws = (unsigned char*)d_ws;
    hipMemsetAsync((unsigned char*)d_ws + OFF_BAR, 0, XCD_BAR_WORDS * sizeof(unsigned), stream);
    void* args[] = {&p};
    hipError_t e = hipLaunchCooperativeKernel((void*)mega_kernel, dim3(grid_blocks), dim3(512), args, LDS_BYTES, stream);
    if (e != hipSuccess) fprintf(stderr, "cooperative launch failed: %s (grid %d)\n", hipGetErrorString(e), grid_blocks);
}
```

```cpp
#include <hip/hip_runtime.h>
#include <hip/hip_cooperative_groups.h>
#include <cstdio>
#include <cstdint>
namespace cg = cooperative_groups;

#define LAS __attribute__((address_space(3)))
typedef unsigned short bf16_t;
typedef short bf16x8 __attribute__((ext_vector_type(8)));
typedef short s16x4 __attribute__((ext_vector_type(4)));
typedef float f32x4 __attribute__((ext_vector_type(4)));
typedef float f32x2 __attribute__((ext_vector_type(2)));
typedef float f32x16 __attribute__((ext_vector_type(16)));
typedef unsigned u32x4 __attribute__((ext_vector_type(4)));
typedef unsigned u32x2 __attribute__((ext_vector_type(2)));

constexpr int T_ALL = 98304, TG = 49152, DM = 1024, DFF = 2816, NSEQ = 20, MODW = 9216;
constexpr float EPS = 1e-6f;
constexpr size_t XP_ELEMS = 16ull * 4096 * 1024;

constexpr size_t SZ_GU = 5632ull * 1024, SZ_DN = 1024ull * 2816, W_FFN_STRIDE = SZ_GU + SZ_DN, W_FFN_TOTAL = 8 * W_FFN_STRIDE;
constexpr size_t SZ_GIN = 3328ull * 1024, SZ_GOUT = 1024ull * 1024, SZ_MIN = 512ull * 1024, SZ_UQ = 1536ull * 256, SZ_UKV = 2048ull * 256, SZ_MOUT = 1024ull * 1024;
constexpr size_t W_MIX_STRIDE = SZ_GIN + SZ_GOUT + SZ_MIN + SZ_UQ + SZ_UKV + SZ_MOUT;
constexpr size_t W_TOTAL = W_FFN_TOTAL + 2 * W_MIX_STRIDE;
constexpr size_t OFF_W = 0;
constexpr size_t OFF_MOD = OFF_W + W_TOTAL * 2;
constexpr size_t MOD_FLOATS = 4ull * NSEQ * MODW + (size_t)NSEQ * 2048;
constexpr size_t OFF_ROPE = OFF_MOD + MOD_FLOATS * 4;
constexpr size_t OFF_H = OFF_ROPE + 8192ull * 32 * 8;
constexpr size_t OFF_ACT = OFF_H + (size_t)T_ALL * 1024 * 2;
constexpr size_t OFF_BAR = OFF_ACT + (size_t)T_ALL * DFF * 2;
constexpr size_t OFF_SSQ = OFF_BAR + 16384;
constexpr size_t OFF_TB = OFF_SSQ + 2ull * T_ALL * 16 * 4;
constexpr size_t TB_FFN_SZ = 20ull * 5632, TB_PROJ_SZ = 20ull * 3328, TB_CIN_SZ = 20ull * 512;
constexpr size_t TB_FLOATS = 8 * TB_FFN_SZ + 2 * TB_PROJ_SZ + 2 * TB_CIN_SZ;
constexpr size_t WS_NEED = OFF_TB + TB_FLOATS * 4;
static_assert(OFF_MOD % 256 == 0 && OFF_ROPE % 256 == 0 && OFF_H % 256 == 0 && OFF_ACT % 256 == 0, "align");
constexpr size_t GLA_PROJ = 0, GLA_OF = GLA_PROJ + (size_t)TG * 3328 * 2, GLA_OB = GLA_OF + (size_t)TG * 1024 * 2, GLA_END = GLA_OB + (size_t)TG * 1024 * 2;
constexpr size_t MLA_O = 0;
constexpr size_t MLA_CIN = 0, MLA_CN = MLA_CIN + (size_t)TG * 512 * 2, MLA_KR = MLA_CN + (size_t)TG * 512 * 2, MLA_Q = MLA_KR + (size_t)TG * 64 * 2,
                 MLA_KN = MLA_Q + (size_t)TG * 1536 * 2, MLA_V = MLA_KN + (size_t)TG * 1024 * 2, MLA_END = MLA_V + (size_t)TG * 1024 * 2;
static_assert(GLA_END <= (size_t)T_ALL * DFF * 2 && MLA_END <= (size_t)T_ALL * DFF * 2, "act region");

constexpr int LDS_MAIN = 131072, LDS_BYTES = LDS_MAIN + 16;

struct Params {
    const float* in[24];
    float* out;
    unsigned char* ws;
};

__device__ __forceinline__ int opaque_tid() { int t = threadIdx.x; asm volatile("" : "+v"(t)); return t; }
__device__ __forceinline__ int opaque_bid() { int b = blockIdx.x; asm volatile("" : "+s"(b)); return b; }
__device__ __forceinline__ float bf2f(bf16_t b) { return __uint_as_float(((unsigned)b) << 16); }
typedef __bf16 bf16v2 __attribute__((ext_vector_type(2)));
__device__ __forceinline__ bf16_t f2bf(float f) { return __builtin_bit_cast(bf16_t, (__bf16)f); }
__device__ __forceinline__ unsigned cvt_pk_bf16(float lo, float hi) { f32x2 v = {lo, hi}; bf16v2 b = __builtin_convertvector(v, bf16v2); return __builtin_bit_cast(unsigned, b); }
template <int M> __device__ __forceinline__ float swz_xor(float x) { return __int_as_float(__builtin_amdgcn_ds_swizzle(__float_as_int(x), (M << 10) | 0x1F)); }
__device__ __forceinline__ float sum_xor32(float x) { auto rr = __builtin_amdgcn_permlane32_swap(__float_as_uint(x), __float_as_uint(x), false, false); return __uint_as_float(rr[0]) + __uint_as_float(rr[1]); }
__device__ __forceinline__ float get_xor32(float x, int hi) { auto rr = __builtin_amdgcn_permlane32_swap(__float_as_uint(x), __float_as_uint(x), false, false); return hi ? __uint_as_float(rr[0]) : __uint_as_float(rr[1]); }
__device__ __forceinline__ float wave_sum(float x) { x += swz_xor<1>(x); x += swz_xor<2>(x); x += swz_xor<4>(x); x += swz_xor<8>(x); x += swz_xor<16>(x); return sum_xor32(x); }
__device__ __forceinline__ int tok_batch(int t) { return t < 65536 ? (t >> 12) : 16 + ((t - 65536) >> 13); }
__device__ __forceinline__ int tok_pos(int t) { return t < 65536 ? (t & 4095) : ((t - 65536) & 8191); }
__device__ __forceinline__ float silu_f(float g) { return g * __builtin_amdgcn_rcpf(1.0f + __expf(-g)); }
__device__ __forceinline__ float lo_bf(unsigned w) { return __uint_as_float(w << 16); }
__device__ __forceinline__ float hi_bf(unsigned w) { return __uint_as_float(w & 0xffff0000u); }

namespace pg8 {
constexpr int BM = 256, BK = 64, HALF = 128, HTB = HALF * BK * 2, STAGE_BYTES = 8 * HTB, NXCD = 8, WGM = 8;
__device__ __forceinline__ int lds_byte(int r, int c) { const int st = (r >> 4) * 2 + (c >> 5), rr = r & 15, cc = c & 31, ob = rr * 64 + cc * 2; return st * 1024 + (ob ^ (((ob >> 9) & 1) << 5)); }
__device__ __forceinline__ void stage_rc(int b, int& R, int& C) { const int st = b / 1024, sb = b % 1024, swz = sb ^ (((sb >> 9) & 1) << 5); R = (st >> 1) * 16 + swz / 64; C = (st & 1) * 32 + (swz % 64) / 2; }
__device__ __forceinline__ int perm32(int rho) { const int n = rho >> 4, i = rho & 15; return 8 * (i >> 2) + 4 * n + (i & 3); }
struct Unit { int pm, pn; };
struct Gemm { const bf16_t* A; const bf16_t* Bt; int M, N, K, lda, ldb; };
struct StaticOrder {
    int nM, nN, nwg, G, c;
    __device__ void init(int M, int N, int G_, int c_) { nM = M / BM; nN = N / BM; nwg = nM * nN; G = G_; c = c_; }
    __device__ bool next(int i, Unit& u) const {
        const long L = (long)i * G + c; if (L >= nwg) return false;
        int wgid = (int)L; { const int q = nwg / NXCD, r = nwg % NXCD, xcd = wgid % NXCD, off = wgid / NXCD; wgid = (xcd < r ? xcd * (q + 1) : r * (q + 1) + (xcd - r) * q) + off; }
        const int nig = WGM * nN, gid = wgid / nig, fm = gid * WGM, gsz = (nM - fm) < WGM ? (nM - fm) : WGM;
        u.pm = fm + ((wgid % nig) % gsz); u.pn = (wgid % nig) / gsz; return true;
    }
};

template <class Epi>
__device__ __forceinline__ void gemm_phase(LAS unsigned char* lds, const Gemm g, const StaticOrder& S, const Epi& E) {
    const int tid = opaque_tid(), wid = __builtin_amdgcn_readfirstlane(tid >> 6), lane = tid & 63, wr = wid >> 2, wc = wid & 3, fr = lane & 15, fq = lane >> 4;
    const int K = g.K, nt = K / BK;
    unsigned voffA[2], voffB[2];
#pragma unroll
    for (int i = 0; i < 2; ++i) { int R, C; stage_rc(tid * 16 + i * 8192, R, C); const int Rb = Epi::PERM ? ((R & ~31) + perm32(R & 31)) : R;
        voffA[i] = (unsigned)(R * g.lda + C) * 2u; voffB[i] = (unsigned)(Rb * g.ldb + C) * 2u; }
    const size_t kstep = (size_t)(BK * 2);
    const size_t hstepA = (size_t)HALF * g.lda * 2, hstepB = (size_t)HALF * g.ldb * 2;
    const size_t tstepA = 2 * hstepA, tstepB = 2 * hstepB;
    const unsigned ldsw = (unsigned)wid * 1024u;
    const int aoff = lds_byte(wr * 64 + fr, fq * 8), boff = lds_byte(wc * 32 + fr, fq * 8);
#define PG8_SA(b, h) (((b) * 2 + (h)) * HTB)
#define PG8_SB(b, h) ((4 + (b) * 2 + (h)) * HTB)
#define PG8_STAGE(bufoff, gbase, voff) do { _Pragma("unroll") for (int _i = 0; _i < 2; ++_i) \
        __builtin_amdgcn_global_load_lds((const unsigned*)((const char*)(gbase) + (voff)[_i]), (LAS unsigned*)(lds + (bufoff) + ldsw + _i * 8192), 16, 0, 0); } while (0)
#define PG8_LDA(dst, b, h) do { _Pragma("unroll") for (int m = 0; m < 4; ++m) _Pragma("unroll") for (int k = 0; k < 2; ++k) dst[m][k] = *(const LAS bf16x8*)(lds + PG8_SA(b, h) + aoff + m * 2048 + k * 1024); } while (0)
#define PG8_LDB(dst, b, h) do { _Pragma("unroll") for (int n = 0; n < 2; ++n) _Pragma("unroll") for (int k = 0; k < 2; ++k) dst[n][k] = *(const LAS bf16x8*)(lds + PG8_SB(b, h) + boff + n * 2048 + k * 1024); } while (0)
#define PG8_MMA(ai, bj, At, Bt) do { __builtin_amdgcn_s_setprio(1); _Pragma("unroll") for (int m = 0; m < 4; ++m) _Pragma("unroll") for (int n = 0; n < 2; ++n) _Pragma("unroll") for (int k = 0; k < 2; ++k) \
        acc[ai][bj][m][n] = __builtin_amdgcn_mfma_f32_16x16x32_bf16(Bt[n][k], At[m][k], acc[ai][bj][m][n], 0, 0, 0); __builtin_amdgcn_s_setprio(0); } while (0)
#define PG8_WAIT_V(n) asm volatile("s_waitcnt vmcnt(" #n ")" ::: "memory")
#define PG8_WAIT_L(n) asm volatile("s_waitcnt lgkmcnt(" #n ")" ::: "memory")
#define PG8_BAR __builtin_amdgcn_s_barrier()
#define PG8_SCHED __builtin_amdgcn_sched_barrier(0)
    Unit cur, nxt; int ui = 0;
    if (!S.next(0, cur)) return;
    f32x4 acc[2][2][4][2];
#pragma unroll
    for (int a = 0; a < 2; ++a)
#pragma unroll
        for (int b = 0; b < 2; ++b)
#pragma unroll
            for (int m = 0; m < 4; ++m)
#pragma unroll
                for (int n = 0; n < 2; ++n) acc[a][b][m][n] = (f32x4){0.f, 0.f, 0.f, 0.f};
    bf16x8 At[4][2], B0[2][2], B1[2][2];
    const char* cA = (const char*)g.A + (size_t)cur.pm * tstepA; const char* cB = (const char*)g.Bt + (size_t)cur.pn * tstepB;
    PG8_STAGE(PG8_SB(0, 0), cB, voffB); PG8_STAGE(PG8_SA(0, 0), cA, voffA); PG8_STAGE(PG8_SB(0, 1), cB + hstepB, voffB); PG8_STAGE(PG8_SA(0, 1), cA + hstepA, voffA);
    if (wr == 1) PG8_BAR;
    PG8_WAIT_V(4); PG8_BAR;
    PG8_STAGE(PG8_SB(1, 0), cB + kstep, voffB); PG8_STAGE(PG8_SA(1, 0), cA + kstep, voffA); PG8_STAGE(PG8_SB(1, 1), cB + hstepB + kstep, voffB);
    PG8_WAIT_V(6); PG8_BAR;
    for (;;) {
        const bool has_next = S.next(ui + 1, nxt);
        const char* nA = has_next ? (const char*)g.A + (size_t)nxt.pm * tstepA : cA; const char* nB = has_next ? (const char*)g.Bt + (size_t)nxt.pn * tstepB : cB;
#pragma unroll 1
        for (int t = 0; t < nt; t += 2) {
            const bool last = (t == nt - 2);
            const char* a1 = cA + (size_t)(t + 1) * kstep;
            const char* a2 = last ? nA : cA + (size_t)(t + 2) * kstep; const char* b2 = last ? nB : cB + (size_t)(t + 2) * kstep;
            const char* a3 = a2 + kstep; const char* b3 = b2 + kstep;
            PG8_LDB(B0, 0, 0); PG8_SCHED; PG8_LDA(At, 0, 0); PG8_STAGE(PG8_SA(1, 1), a1 + hstepA, voffA);
            PG8_WAIT_L(8); PG8_BAR; PG8_WAIT_L(0); PG8_MMA(0, 0, At, B0); PG8_BAR; PG8_SCHED;
            PG8_LDB(B1, 0, 1); PG8_STAGE(PG8_SB(0, 0), b2, voffB);
            PG8_BAR; PG8_WAIT_L(0); PG8_MMA(0, 1, At, B1); PG8_BAR;
            PG8_LDA(At, 0, 1); PG8_STAGE(PG8_SA(0, 0), a2, voffA);
            PG8_BAR; PG8_WAIT_L(0); PG8_MMA(1, 0, At, B0); PG8_BAR; PG8_SCHED;
            PG8_STAGE(PG8_SB(0, 1), b2 + hstepB, voffB);
            PG8_WAIT_V(6); PG8_BAR; PG8_MMA(1, 1, At, B1); PG8_BAR;
            PG8_LDB(B0, 1, 0); PG8_SCHED; PG8_LDA(At, 1, 0); PG8_STAGE(PG8_SA(0, 1), a2 + hstepA, voffA);
            PG8_WAIT_L(8); PG8_BAR; PG8_WAIT_L(0); PG8_MMA(0, 0, At, B0); PG8_BAR; PG8_SCHED;
            PG8_LDB(B1, 1, 1); PG8_STAGE(PG8_SB(1, 0), b3, voffB);
            PG8_BAR; PG8_WAIT_L(0); PG8_MMA(0, 1, At, B1); PG8_BAR;
            PG8_LDA(At, 1, 1); PG8_STAGE(PG8_SA(1, 0), a3, voffA);
            PG8_BAR; PG8_WAIT_L(0); PG8_MMA(1, 0, At, B0); PG8_BAR; PG8_SCHED;
            PG8_STAGE(PG8_SB(1, 1), b3 + hstepB, voffB);
            PG8_WAIT_V(6); PG8_BAR; PG8_MMA(1, 1, At, B1); PG8_BAR;
        }
        E(acc, cur, wr, wc, fr, fq);
        if (!has_next) break;
#pragma unroll
        for (int a = 0; a < 2; ++a)
#pragma unroll
            for (int b = 0; b < 2; ++b)
#pragma unroll
                for (int m = 0; m < 4; ++m)
#pragma unroll
                    for (int n = 0; n < 2; ++n) acc[a][b][m][n] = (f32x4){0.f, 0.f, 0.f, 0.f};
        cur = nxt; cA = nA; cB = nB; ++ui;
    }
    PG8_WAIT_V(0);
    if (wr == 0) PG8_BAR;
    PG8_BAR;
#undef PG8_SA
#undef PG8_SB
#undef PG8_STAGE
#undef PG8_LDA
#undef PG8_LDB
#undef PG8_MMA
#undef PG8_WAIT_V
#undef PG8_WAIT_L
#undef PG8_BAR
#undef PG8_SCHED
}

__device__ __forceinline__ void rows_rstd(const float* ssq, int row0, int fq, float (&rsv)[8]) {
    f32x4 q[8];
#pragma unroll
    for (int r = 0; r < 8; ++r) q[r] = *(const f32x4*)(ssq + (size_t)(row0 + (r >> 2) * 128 + (r & 3) * 16) * 16 + 4 * fq);
#pragma unroll
    for (int r = 0; r < 8; ++r) { float a = (q[r][0] + q[r][1]) + (q[r][2] + q[r][3]); a += swz_xor<16>(a); a = sum_xor32(a); rsv[r] = rsqrtf(a * (1.0f / 1024.0f) + EPS); }
}
struct EpiGateUp {
    static constexpr bool PERM = false;
    bf16_t* O; const float* ssq; const float* tb;
    __device__ __forceinline__ void operator()(const f32x4 (&acc)[2][2][4][2], const Unit& u, int wr, int wc, int fr, int fq) const {
        const int row0 = u.pm * BM + wr * 64 + fr, col = u.pn * 128 + wc * 32 + fq * 8;
        const int b = tok_batch(u.pm * 256);
        const float* tbp = tb + (size_t)b * 5632 + u.pn * BM + wc * 32 + 4 * fq;
        const f32x4 tg0 = *(const f32x4*)(tbp), tu0 = *(const f32x4*)(tbp + 16), tg1 = *(const f32x4*)(tbp + HALF), tu1 = *(const f32x4*)(tbp + HALF + 16);
        float rsv[8]; rows_rstd(ssq, row0, fq, rsv);
#pragma unroll
        for (int ai = 0; ai < 2; ++ai)
#pragma unroll
            for (int m = 0; m < 4; ++m) {
                const int row = row0 + ai * HALF + m * 16;
                const float rs = rsv[ai * 4 + m];
                bf16_t* dst = O + (size_t)row * DFF + col;
                const f32x4 g0 = acc[ai][0][m][0] * rs + tg0, u0 = acc[ai][0][m][1] * rs + tu0, g1 = acc[ai][1][m][0] * rs + tg1, u1 = acc[ai][1][m][1] * rs + tu1;
                u32x4 w;
                w.x = cvt_pk_bf16(silu_f(g0[0]) * u0[0], silu_f(g0[1]) * u0[1]); w.y = cvt_pk_bf16(silu_f(g0[2]) * u0[2], silu_f(g0[3]) * u0[3]);
                w.z = cvt_pk_bf16(silu_f(g1[0]) * u1[0], silu_f(g1[1]) * u1[1]); w.w = cvt_pk_bf16(silu_f(g1[2]) * u1[2], silu_f(g1[3]) * u1[3]);
                *(u32x4*)dst = w;
            }
    }
};
__device__ __forceinline__ f32x4 safe_rcp4(f32x4 v) { f32x4 r; for (int e = 0; e < 4; ++e) r[e] = v[e] != 0.f ? 1.0f / v[e] : 0.f; return r; }
struct EpiResid {
    static constexpr bool PERM = false;
    const float* gate; float coef; int tile0;
    bf16_t* XS; const float* gprev; const float* scprev; const float* gnext; const float* scnext; float* ssq;
    __device__ __forceinline__ void operator()(f32x4 (&acc)[2][2][4][2], const Unit& u, int wr, int wc, int fr, int fq) const {
        int upm = u.pm, upn = u.pn; float cf = coef;
        typedef __attribute__((address_space(1))) float gf32; typedef __attribute__((address_space(1))) bf16_t gbf16;
        typedef __attribute__((address_space(1))) f32x4 gf32x4; typedef __attribute__((address_space(1))) u32x2 gu32x2;
        gbf16* XSp = (gbf16*)XS; gf32* sqp = (gf32*)ssq; const gf32* gtp = (const gf32*)gate; const gf32* gnp = (const gf32*)gnext; const gf32* scp = (const gf32*)scnext;
        const gf32* gpp = (const gf32*)gprev; const gf32* spp = (const gf32*)scprev;
        asm volatile("" : "+s"(upm), "+s"(upn), "+v"(cf), "+s"(XSp), "+s"(sqp), "+s"(gtp), "+s"(gnp), "+s"(scp), "+s"(gpp), "+s"(spp));
        const int row0 = upm * BM + wr * 64 + fr, col0 = upn * BM + wc * 32 + 4 * fq;
        const int b = tok_batch((tile0 + upm) * 256);
        f32x4 t0[2][2], t1[2][2], t2[2][2], inv[2][2], cs[2][2]; u32x2 xr[3][2][2];
#pragma unroll
        for (int bj = 0; bj < 2; ++bj)
#pragma unroll
            for (int n = 0; n < 2; ++n) { t0[bj][n] = *(const gf32x4*)(gtp + (size_t)b * MODW + col0 + bj * HALF + n * 16);
                t1[bj][n] = *(const gf32x4*)(gpp + col0 + bj * HALF + n * 16);
                t2[bj][n] = *(const gf32x4*)(spp + (size_t)b * MODW + col0 + bj * HALF + n * 16); }
#pragma unroll
        for (int q = 0; q < 2; ++q)
#pragma unroll
            for (int bj = 0; bj < 2; ++bj)
#pragma unroll
                for (int n = 0; n < 2; ++n) xr[q][bj][n] = *(const gu32x2*)(XSp + (size_t)(row0 + q * 16) * DM + col0 + bj * HALF + n * 16);
        __builtin_amdgcn_sched_barrier(0);
#pragma unroll
        for (int bj = 0; bj < 2; ++bj)
#pragma unroll
            for (int n = 0; n < 2; ++n) { const f32x4 g = t0[bj][n] * cf; inv[bj][n] = safe_rcp4(t1[bj][n] * (t2[bj][n] + 1.0f));
#pragma unroll
                for (int ai = 0; ai < 2; ++ai)
#pragma unroll
                    for (int m = 0; m < 4; ++m) acc[ai][bj][m][n] = acc[ai][bj][m][n] * g; }
        __builtin_amdgcn_sched_barrier(0);
#pragma unroll
        for (int bj = 0; bj < 2; ++bj)
#pragma unroll
            for (int n = 0; n < 2; ++n) { t0[bj][n] = *(const gf32x4*)(gnp + col0 + bj * HALF + n * 16); t1[bj][n] = *(const gf32x4*)(scp + (size_t)b * MODW + col0 + bj * HALF + n * 16); }
        __builtin_amdgcn_sched_barrier(0);
#pragma unroll
        for (int bj = 0; bj < 2; ++bj)
#pragma unroll
            for (int n = 0; n < 2; ++n) cs[bj][n] = t0[bj][n] * (t1[bj][n] + 1.0f);
#pragma unroll
        for (int r = 0; r < 8; ++r) {
            const int ai = r >> 2, m = r & 3;
            const int row = row0 + ai * HALF + m * 16; float ss = 0.f;
            if (r + 2 < 8) { const int rown = row0 + ((r + 2) >> 2) * HALF + ((r + 2) & 3) * 16;
#pragma unroll
                for (int bj = 0; bj < 2; ++bj)
#pragma unroll
                    for (int n = 0; n < 2; ++n) xr[(r + 2) % 3][bj][n] = *(const gu32x2*)(XSp + (size_t)rown * DM + col0 + bj * HALF + n * 16); }
#pragma unroll
            for (int bj = 0; bj < 2; ++bj)
#pragma unroll
                for (int n = 0; n < 2; ++n) { const u32x2 xo = xr[r % 3][bj][n];
                    const f32x4 xn = (f32x4){lo_bf(xo.x), hi_bf(xo.x), lo_bf(xo.y), hi_bf(xo.y)} * inv[bj][n] + acc[ai][bj][m][n];
                    ss += (xn[0] * xn[0] + xn[1] * xn[1]) + (xn[2] * xn[2] + xn[3] * xn[3]); const f32x4 y = xn * cs[bj][n];
                    u32x2 w; w.x = cvt_pk_bf16(y[0], y[1]); w.y = cvt_pk_bf16(y[2], y[3]); *(gu32x2*)(XSp + (size_t)row * DM + col0 + bj * HALF + n * 16) = w; }
            ss += swz_xor<16>(ss); ss = sum_xor32(ss); sqp[(size_t)row * 16 + upn * 4 + wc] = ss;
            __builtin_amdgcn_sched_barrier(0);
        }
    }
};
struct EpiResidLast {
    static constexpr bool PERM = false;
    const bf16_t* XS; const float* gprev; const float* scprev; const float* gate; float coef; float* lo; float* hi_;
    __device__ __forceinline__ void operator()(f32x4 (&acc)[2][2][4][2], const Unit& u, int wr, int wc, int fr, int fq) const {
        const int row0 = u.pm * BM + wr * 64 + fr, col0 = u.pn * BM + wc * 32 + 4 * fq;
        const int b = tok_batch(u.pm * 256);
        float* dst = (u.pm * BM < T_ALL / 2) ? lo : hi_;
        f32x4 gv[2][2], inv[2][2];
#pragma unroll
        for (int bj = 0; bj < 2; ++bj)
#pragma unroll
            for (int n = 0; n < 2; ++n) { gv[bj][n] = *(const f32x4*)(gate + (size_t)b * MODW + col0 + bj * HALF + n * 16) * coef;
                inv[bj][n] = safe_rcp4(*(const f32x4*)(gprev + col0 + bj * HALF + n * 16) * (*(const f32x4*)(scprev + (size_t)b * MODW + col0 + bj * HALF + n * 16) + 1.0f)); }
#pragma unroll
        for (int ai = 0; ai < 2; ++ai)
#pragma unroll
            for (int m = 0; m < 4; ++m) { const int row = row0 + ai * HALF + m * 16;
                u32x2 xo[2][2];
#pragma unroll
                for (int bj = 0; bj < 2; ++bj)
#pragma unroll
                    for (int n = 0; n < 2; ++n) xo[bj][n] = *(const u32x2*)(XS + (size_t)row * DM + col0 + bj * HALF + n * 16);
#pragma unroll
                for (int bj = 0; bj < 2; ++bj)
#pragma unroll
                    for (int n = 0; n < 2; ++n) { const u32x2 q = xo[bj][n];
                        *(f32x4*)(dst + (size_t)row * DM + col0 + bj * HALF + n * 16) = (f32x4){lo_bf(q.x), hi_bf(q.x), lo_bf(q.y), hi_bf(q.y)} * inv[bj][n] + gv[bj][n] * acc[ai][bj][m][n]; } }
    }
};
struct EpiBf16 {
    static constexpr bool PERM = true;
    bf16_t* O; int ldc;
    __device__ __forceinline__ void operator()(const f32x4 (&acc)[2][2][4][2], const Unit& u, int wr, int wc, int fr, int fq) const {
        const int row0 = u.pm * BM + wr * 64 + fr, col0 = u.pn * BM + wc * 32 + 8 * fq;
#pragma unroll
        for (int ai = 0; ai < 2; ++ai)
#pragma unroll
            for (int m = 0; m < 4; ++m) { bf16_t* rowp = O + (size_t)(row0 + ai * HALF + m * 16) * ldc + col0;
#pragma unroll
                for (int bj = 0; bj < 2; ++bj) { const f32x4 v0 = acc[ai][bj][m][0], v1 = acc[ai][bj][m][1];
                    u32x4 w; w.x = cvt_pk_bf16(v0[0], v0[1]); w.y = cvt_pk_bf16(v0[2], v0[3]); w.z = cvt_pk_bf16(v1[0], v1[1]); w.w = cvt_pk_bf16(v1[2], v1[3]);
                    *(u32x4*)(rowp + bj * HALF) = w; } }
    }
};
struct EpiBf16N {
    static constexpr bool PERM = true;
    bf16_t* O; int ldc; const float* ssq; const float* tb; int ldtb; int tile0;
    __device__ __forceinline__ void operator()(const f32x4 (&acc)[2][2][4][2], const Unit& u, int wr, int wc, int fr, int fq) const {
        const int row0 = u.pm * BM + wr * 64 + fr, col0 = u.pn * BM + wc * 32 + 8 * fq;
        const int b = tok_batch((tile0 + u.pm) * 256);
        const float* tbp = tb + (size_t)b * ldtb + col0;
        const f32x4 t00 = *(const f32x4*)(tbp), t01 = *(const f32x4*)(tbp + 4), t10 = *(const f32x4*)(tbp + HALF), t11 = *(const f32x4*)(tbp + HALF + 4);
        float rsv[8]; rows_rstd(ssq, row0, fq, rsv);
#pragma unroll
        for (int ai = 0; ai < 2; ++ai)
#pragma unroll
            for (int m = 0; m < 4; ++m) { const int row = row0 + ai * HALF + m * 16; bf16_t* rowp = O + (size_t)row * ldc + col0;
                const float rs = rsv[ai * 4 + m];
#pragma unroll
                for (int bj = 0; bj < 2; ++bj) { const f32x4 v0 = acc[ai][bj][m][0] * rs + (bj ? t10 : t00), v1 = acc[ai][bj][m][1] * rs + (bj ? t11 : t01);
                    u32x4 w; w.x = cvt_pk_bf16(v0[0], v0[1]); w.y = cvt_pk_bf16(v0[2], v0[3]); w.z = cvt_pk_bf16(v1[0], v1[1]); w.w = cvt_pk_bf16(v1[2], v1[3]);
                    *(u32x4*)(rowp + bj * HALF) = w; } }
    }
};
struct EpiKV {
    static constexpr bool PERM = true;
    bf16_t* Kn; bf16_t* V;
    __device__ __forceinline__ void operator()(const f32x4 (&acc)[2][2][4][2], const Unit& u, int wr, int wc, int fr, int fq) const {
        const int row0 = u.pm * BM + wr * 64 + fr, col0 = u.pn * 128 + wc * 32 + 8 * fq;
#pragma unroll
        for (int ai = 0; ai < 2; ++ai)
#pragma unroll
            for (int m = 0; m < 4; ++m) { const size_t off = (size_t)(row0 + ai * HALF + m * 16) * 1024 + col0;
#pragma unroll
                for (int bj = 0; bj < 2; ++bj) { const f32x4 v0 = acc[ai][bj][m][0], v1 = acc[ai][bj][m][1];
                    u32x4 w; w.x = cvt_pk_bf16(v0[0], v0[1]); w.y = cvt_pk_bf16(v0[2], v0[3]); w.z = cvt_pk_bf16(v1[0], v1[1]); w.w = cvt_pk_bf16(v1[2], v1[3]);
                    *(u32x4*)((bj ? V : Kn) + off) = w; } }
    }
};
}

template <class Epi>
__device__ __forceinline__ void run_gemm(LAS unsigned char* lds, const bf16_t* A, int lda, const bf16_t* Bt, int ldb, int M, int N, int K, const Epi& E) {
    pg8::Gemm g; g.A = A; g.Bt = Bt; g.M = M; g.N = N; g.K = K; g.lda = lda; g.ldb = ldb;
    pg8::StaticOrder S; S.init(M, N, (int)gridDim.x, opaque_bid());
    pg8::gemm_phase<Epi>(lds, g, S, E);
}

__device__ __forceinline__ void prep_mod(const Params& p, unsigned char* shm) {
    float* cact = (float*)shm;
    float* red = (float*)(shm + 81920);
    const int tid = opaque_tid(), bid = opaque_bid();
    if (bid >= 304) return;
    for (int idx = tid; idx < NSEQ * 1024; idx += 512) {
        const int b = idx >> 10, k = idx & 1023;
        const float c = b < 16 ? p.in[2][b * 1024 + k] : p.in[3][(b - 16) * 1024 + k];
        cact[k * NSEQ + b] = c / (1.0f + expf(-c));
    }
    __syncthreads();
    float* modbase = (float*)(p.ws + OFF_MOD);
    for (int it = bid; it < 304; it += gridDim.x) {
        const int mat = it < 288 ? it / 72 : 4, chunk = it < 288 ? it % 72 : it - 288, n0 = chunk * 128;
        const float* W = mat < 4 ? p.in[4] + (size_t)mat * 1024 * MODW : p.in[21];
        const float* bias = mat < 4 ? p.in[5] + mat * MODW : p.in[22];
        const int ldw = mat < 4 ? MODW : 2048;
        float* outp = mat < 4 ? modbase + (size_t)mat * NSEQ * MODW : modbase + 4ull * NSEQ * MODW;
        const int nl = tid & 127, ks = tid >> 7;
        float acc[NSEQ];
#pragma unroll
        for (int b = 0; b < NSEQ; ++b) acc[b] = 0.f;
        const float* wp = W + (size_t)(ks * 256) * ldw + n0 + nl;
#pragma unroll 4
        for (int k = 0; k < 256; ++k) {
            const float w = wp[(size_t)k * ldw];
            const f32x4* cv = (const f32x4*)(cact + (ks * 256 + k) * NSEQ);
#pragma unroll
            for (int q = 0; q < 5; ++q) { const f32x4 c4 = cv[q]; acc[q * 4 + 0] += c4[0] * w; acc[q * 4 + 1] += c4[1] * w; acc[q * 4 + 2] += c4[2] * w; acc[q * 4 + 3] += c4[3] * w; }
        }
#pragma unroll
        for (int b = 0; b < NSEQ; ++b) red[(ks * 128 + nl) * NSEQ + b] = acc[b];
        __syncthreads();
        for (int o = tid; o < 128 * NSEQ; o += 512) {
            const int b = o >> 7, n = o & 127;
            const float s = red[(0 * 128 + n) * NSEQ + b] + red[(1 * 128 + n) * NSEQ + b] + red[(2 * 128 + n) * NSEQ + b] + red[(3 * 128 + n) * NSEQ + b];
            outp[(size_t)b * ldw + n0 + n] = s + bias[n0 + n];
        }
        __syncthreads();
    }
}

__device__ __forceinline__ void prep_rope(const Params& p) {
    f32x2* tab = (f32x2*)(p.ws + OFF_ROPE);
    for (int i = opaque_bid() * 512 + opaque_tid(); i < 8192 * 32; i += gridDim.x * 512) {
        const int pos = i >> 5, j = i & 31;
        const float inv = 1.0f / powf(10000.0f, (float)(2 * j) / 64.0f);
        const float ang = (float)pos * inv;
        float s, c; sincosf(ang, &s, &c);
        tab[i] = (f32x2){c, s};
    }
}

__device__ __forceinline__ void prep_weights(const Params& p, unsigned char* shm) {
    float* tile = (float*)shm;
    const int tid = opaque_tid();
    bf16_t* Wb = (bf16_t*)(p.ws + OFF_W);
    constexpr int T_GU = 88 * 8, T_DN = 16 * 22, T_FFN = T_GU + T_DN, T_FFN_ALL = 8 * T_FFN;
    constexpr int T_GIN = 52 * 8, T_GOUT = 128, T_MIN = 8 * 8, T_UQ = 24 * 2, T_UKV = 32 * 2, T_MOUT = 128, T_MIX = T_GIN + T_GOUT + T_MIN + T_UQ + T_UKV + T_MOUT;
    constexpr int T_TOTAL = T_FFN_ALL + 2 * T_MIX;
    for (int idx = opaque_bid(); idx < T_TOTAL; idx += gridDim.x) {
        const float* src; const float* src2 = nullptr; int ldsrc, ksrc, nsrc, ldk, NT, mode = 0, loc; bf16_t* dst;
        if (idx < T_FFN_ALL) {
            const int lw = idx / T_FFN; loc = idx % T_FFN;
            if (loc < T_GU) { src = p.in[7] + (size_t)lw * 1024 * DFF; src2 = p.in[8] + (size_t)lw * 1024 * DFF; ldsrc = DFF; ksrc = 1024; nsrc = DFF; ldk = 1024; NT = 88; mode = 1; dst = Wb + (size_t)lw * W_FFN_STRIDE; }
            else { loc -= T_GU; src = p.in[9] + (size_t)lw * DFF * 1024; ldsrc = 1024; ksrc = DFF; nsrc = 1024; ldk = DFF; NT = 16; dst = Wb + (size_t)lw * W_FFN_STRIDE + SZ_GU; }
        } else {
            const int r = idx - T_FFN_ALL, j = r / T_MIX; loc = r % T_MIX;
            bf16_t* mb = Wb + W_FFN_TOTAL + (size_t)j * W_MIX_STRIDE;
            if (loc < T_GIN) { src = p.in[10] + (size_t)j * 1024 * 3104; ldsrc = 3104; ksrc = 1024; nsrc = 3104; ldk = 1024; NT = 52; dst = mb; }
            else if ((loc -= T_GIN) < T_GOUT) { src = p.in[14] + (size_t)j * 1024 * 1024; ldsrc = 1024; ksrc = 1024; nsrc = 1024; ldk = 1024; NT = 16; dst = mb + SZ_GIN; }
            else if ((loc -= T_GOUT) < T_MIN) { src = p.in[15] + (size_t)j * 1024 * 448; ldsrc = 448; ksrc = 1024; nsrc = 448; ldk = 1024; NT = 8; dst = mb + SZ_GIN + SZ_GOUT; }
            else if ((loc -= T_MIN) < T_UQ) { src = p.in[18] + (size_t)j * 256 * 1536; ldsrc = 1536; ksrc = 256; nsrc = 1536; ldk = 256; NT = 24; dst = mb + SZ_GIN + SZ_GOUT + SZ_MIN; }
            else if ((loc -= T_UQ) < T_UKV) { src = p.in[19] + (size_t)j * 128 * 2048; ldsrc = 2048; ksrc = 128; nsrc = 2048; ldk = 256; NT = 32; dst = mb + SZ_GIN + SZ_GOUT + SZ_MIN + SZ_UQ; }
            else { loc -= T_UKV; src = p.in[20] + (size_t)j * 1024 * 1024; ldsrc = 1024; ksrc = 1024; nsrc = 1024; ldk = 1024; NT = 16; dst = mb + SZ_GIN + SZ_GOUT + SZ_MIN + SZ_UQ + SZ_UKV; }
        }
        const int n0 = (loc % NT) * 64, k0 = (loc / NT) * 128;
        {
            const int j = tid & 63, kk = tid >> 6;
            int col = n0 + j; const float* sp = src;
            if (mode == 1) { const int nsel = n0 >= DFF ? 1 : 0; col = n0 - nsel * DFF + j; sp = nsel ? src2 : src; }
#pragma unroll
            for (int i = 0; i < 16; ++i) { const int k = k0 + kk + 8 * i;
                tile[(kk + 8 * i) * 65 + j] = (k < ksrc && col < nsrc) ? sp[(size_t)k * ldsrc + col] : 0.f; }
        }
        __syncthreads();
        {
            const int j = tid >> 3, kc = (tid & 7) * 8;
            int drow = n0 + j;
            if (mode == 1) { const int nsel = n0 >= DFF ? 1 : 0, c = n0 - nsel * DFF + j;
                drow = 256 * (c >> 7) + 128 * ((c >> 2) & 1) + 32 * ((c >> 5) & 3) + 16 * nsel + 4 * ((c >> 3) & 3) + (c & 3); }
#pragma unroll
            for (int h = 0; h < 2; ++h) {
                float v[8];
#pragma unroll
                for (int e = 0; e < 8; ++e) v[e] = tile[(h * 64 + kc + e) * 65 + j];
                u32x4 w; w.x = cvt_pk_bf16(v[0], v[1]); w.y = cvt_pk_bf16(v[2], v[3]); w.z = cvt_pk_bf16(v[4], v[5]); w.w = cvt_pk_bf16(v[6], v[7]);
                *(u32x4*)(dst + (size_t)drow * ldk + k0 + h * 64 + kc) = w;
            }
        }
        __syncthreads();
    }
}

__device__ __forceinline__ void phase_tb(const Params& p, unsigned char* shm) {
    float* sh = (float*)shm;
    const int tid = opaque_tid(), wid = tid >> 6, lane = tid & 63;
    const bf16_t* Wb = (const bf16_t*)(p.ws + OFF_W);
    const float* modb = (const float*)(p.ws + OFF_MOD);
    float* tball = (float*)(p.ws + OFF_TB);
    constexpr int U_FFN = 88, U_PROJ = 52, U_CIN = 8, U_TOTAL = 8 * U_FFN + 2 * U_PROJ + 2 * U_CIN;
    int loaded = -1;
    for (int un = opaque_bid(); un < U_TOTAL; un += gridDim.x) {
        int tab, chunk, N; const bf16_t* W; const float* shift; float* out;
        if (un < 8 * U_FFN) { tab = un / U_FFN; chunk = un % U_FFN; N = 5632; const int l = tab >> 1, w = tab & 1;
            W = Wb + (size_t)tab * W_FFN_STRIDE; shift = modb + (size_t)l * NSEQ * MODW + (w ? 6 : 0) * 1024; out = tball + (size_t)tab * TB_FFN_SZ; }
        else if (un < 8 * U_FFN + 2 * U_PROJ) { const int r = un - 8 * U_FFN, j = r / U_PROJ; chunk = r % U_PROJ; tab = 8 + j; N = 3328;
            W = Wb + W_FFN_TOTAL + (size_t)j * W_MIX_STRIDE; shift = modb + (size_t)(2 * j) * NSEQ * MODW + 3 * 1024; out = tball + 8 * TB_FFN_SZ + (size_t)j * TB_PROJ_SZ; }
        else { const int r = un - 8 * U_FFN - 2 * U_PROJ, j = r / U_CIN; chunk = r % U_CIN; tab = 10 + j; N = 512;
            W = Wb + W_FFN_TOTAL + (size_t)j * W_MIX_STRIDE + SZ_GIN + SZ_GOUT; shift = modb + (size_t)(2 * j + 1) * NSEQ * MODW + 3 * 1024; out = tball + 8 * TB_FFN_SZ + 2 * TB_PROJ_SZ + (size_t)j * TB_CIN_SZ; }
        if (tab != loaded) {
            __syncthreads();
            for (int i = tid; i < NSEQ * 1024; i += 512) sh[i] = shift[(size_t)(i >> 10) * MODW + (i & 1023)];
            __syncthreads();
            loaded = tab;
        }
#pragma unroll 1
        for (int rr = 0; rr < 8; ++rr) {
            const int n = chunk * 64 + wid * 8 + rr;
            const u32x4 w0 = *(const u32x4*)(W + (size_t)n * 1024 + lane * 16), w1 = *(const u32x4*)(W + (size_t)n * 1024 + lane * 16 + 8);
            float wv[16];
#pragma unroll
            for (int q = 0; q < 4; ++q) { wv[2 * q] = lo_bf(w0[q]); wv[2 * q + 1] = hi_bf(w0[q]); wv[8 + 2 * q] = lo_bf(w1[q]); wv[8 + 2 * q + 1] = hi_bf(w1[q]); }
            float mine = 0.f;
#pragma unroll 2
            for (int bb = 0; bb < NSEQ; ++bb) {
                const f32x4* sp = (const f32x4*)(sh + bb * 1024 + lane * 16);
                float a = 0.f;
#pragma unroll
                for (int q = 0; q < 4; ++q) { const f32x4 s4 = sp[q]; a += s4[0] * wv[4 * q] + s4[1] * wv[4 * q + 1] + s4[2] * wv[4 * q + 2] + s4[3] * wv[4 * q + 3]; }
                a = wave_sum(a);
                mine = (lane == bb) ? a : mine;
            }
            if (lane < NSEQ) out[(size_t)lane * N + n] = mine;
        }
    }
}

__device__ __forceinline__ void phase_prenorm(const Params& p) {
    const int tid = opaque_tid(), wid = tid >> 6, lane = tid & 63;
    const float* g = p.in[6]; const float* scale = (const float*)(p.ws + OFF_MOD) + 1024;
    bf16_t* XS = (bf16_t*)p.out; float* ssq = (float*)(p.ws + OFF_SSQ);
    for (int row = opaque_bid() * 8 + wid; row < T_ALL; row += gridDim.x * 8) {
        const int b = tok_batch(row);
        const float* xr = row < 65536 ? p.in[0] + (size_t)row * DM : p.in[1] + (size_t)(row - 65536) * DM;
        f32x4 v[4]; float ss = 0.f;
#pragma unroll
        for (int j = 0; j < 4; ++j) { v[j] = *(const f32x4*)(xr + j * 256 + lane * 4); ss += v[j][0] * v[j][0] + v[j][1] * v[j][1] + v[j][2] * v[j][2] + v[j][3] * v[j][3]; }
        ss = wave_sum(ss);
        if (lane < 16) ssq[(size_t)row * 16 + lane] = lane == 0 ? ss : 0.f;
#pragma unroll
        for (int j = 0; j < 4; ++j) {
            const int c = j * 256 + lane * 4;
            const f32x4 gg = *(const f32x4*)(g + c), sc = *(const f32x4*)(scale + (size_t)b * MODW + c);
            const f32x4 y = v[j] * gg * (sc + 1.0f);
            u32x2 w; w.x = cvt_pk_bf16(y[0], y[1]); w.y = cvt_pk_bf16(y[2], y[3]); *(u32x2*)(XS + (size_t)row * DM + c) = w;
        }
    }
}

__device__ __forceinline__ void phase_final(const float* xlo, float* out, const float* g, const float* shift, const float* scale, int ldmod) {
    const int tid = opaque_tid(), wid = tid >> 6, lane = tid & 63;
    for (int row = opaque_bid() * 8 + wid; row < T_ALL; row += gridDim.x * 8) {
        const int b = tok_batch(row);
        const float* xr = (row < T_ALL / 2 ? xlo : (const float*)out) + (size_t)row * DM;
        f32x4 v[4]; float ss = 0.f;
#pragma unroll
        for (int j = 0; j < 4; ++j) { v[j] = *(const f32x4*)(xr + j * 256 + lane * 4); ss += v[j][0] * v[j][0] + v[j][1] * v[j][1] + v[j][2] * v[j][2] + v[j][3] * v[j][3]; }
        ss = wave_sum(ss);
        const float rstd = rsqrtf(ss * (1.0f / 1024.0f) + EPS);
#pragma unroll
        for (int j = 0; j < 4; ++j) {
            const int c = j * 256 + lane * 4;
            const f32x4 gg = *(const f32x4*)(g + c), sh = *(const f32x4*)(shift + (size_t)b * ldmod + c), sc = *(const f32x4*)(scale + (size_t)b * ldmod + c);
            f32x4 y;
#pragma unroll
            for (int e = 0; e < 4; ++e) y[e] = (v[j][e] * rstd * gg[e]) * (1.0f + sc[e]) + sh[e];
            *(f32x4*)(out + (size_t)row * DM + c) = y;
        }
    }
}

__device__ __forceinline__ void phase_gla_combine(const Params& p, int j, int grp) {
    const bf16_t* proj = (const bf16_t*)(p.ws + OFF_ACT + GLA_PROJ);
    const bf16_t* of = (const bf16_t*)(p.ws + OFF_ACT + GLA_OF);
    const bf16_t* ob = (const bf16_t*)(p.ws + OFF_ACT + GLA_OB);
    bf16_t* gated = (bf16_t*)(p.ws + OFF_ACT + GLA_OF);
    const float* gn = p.in[13] + j * 256;
    const int tid = opaque_tid(), wid = tid >> 6, lane = tid & 63;
    float gnv[16];
#pragma unroll
    for (int e = 0; e < 16; ++e) gnv[e] = gn[((lane & 15) * 16 + e)];
    for (int tok = opaque_bid() * 8 + wid; tok < TG; tok += gridDim.x * 8) {
        const u32x4 f0 = *(const u32x4*)(of + (size_t)tok * 1024 + lane * 16), f1 = *(const u32x4*)(of + (size_t)tok * 1024 + lane * 16 + 8);
        const u32x4 b0 = *(const u32x4*)(ob + (size_t)tok * 1024 + lane * 16), b1 = *(const u32x4*)(ob + (size_t)tok * 1024 + lane * 16 + 8);
        const u32x4 r0 = *(const u32x4*)(proj + (size_t)tok * 3328 + 2048 + lane * 16), r1 = *(const u32x4*)(proj + (size_t)tok * 3328 + 2048 + lane * 16 + 8);
        float o[16], r[16];
#pragma unroll
        for (int q = 0; q < 4; ++q) {
            o[2 * q] = lo_bf(f0[q]) + lo_bf(b0[q]); o[2 * q + 1] = hi_bf(f0[q]) + hi_bf(b0[q]);
            o[8 + 2 * q] = lo_bf(f1[q]) + lo_bf(b1[q]); o[8 + 2 * q + 1] = hi_bf(f1[q]) + hi_bf(b1[q]);
            r[2 * q] = lo_bf(r0[q]); r[2 * q + 1] = hi_bf(r0[q]); r[8 + 2 * q] = lo_bf(r1[q]); r[8 + 2 * q + 1] = hi_bf(r1[q]);
        }
        float ss = 0.f;
#pragma unroll
        for (int e = 0; e < 16; ++e) ss += o[e] * o[e];
        ss += swz_xor<1>(ss); ss += swz_xor<2>(ss); ss += swz_xor<4>(ss); ss += swz_xor<8>(ss);
        const float rstd = rsqrtf(ss * (1.0f / 256.0f) + EPS);
        float y[16];
#pragma unroll
        for (int e = 0; e < 16; ++e) y[e] = silu_f(r[e]) * (o[e] * rstd * gnv[e]);
        u32x4 w0, w1;
        w0.x = cvt_pk_bf16(y[0], y[1]); w0.y = cvt_pk_bf16(y[2], y[3]); w0.z = cvt_pk_bf16(y[4], y[5]); w0.w = cvt_pk_bf16(y[6], y[7]);
        w1.x = cvt_pk_bf16(y[8], y[9]); w1.y = cvt_pk_bf16(y[10], y[11]); w1.z = cvt_pk_bf16(y[12], y[13]); w1.w = cvt_pk_bf16(y[14], y[15]);
        *(u32x4*)(gated + (size_t)tok * 1024 + lane * 16) = w0; *(u32x4*)(gated + (size_t)tok * 1024 + lane * 16 + 8) = w1;
    }
}

__device__ __forceinline__ void phase_mla_normrope(const Params& p, int j, int grp) {
    const bf16_t* cin = (const bf16_t*)(p.ws + OFF_ACT + MLA_CIN);
    bf16_t* cn = (bf16_t*)(p.ws + OFF_ACT + MLA_CN);
    bf16_t* kr = (bf16_t*)(p.ws + OFF_ACT + MLA_KR);
    const f32x2* rope = (const f32x2*)(p.ws + OFF_ROPE);
    const float* gq = p.in[16] + j * 256; const float* gkv = p.in[17] + j * 128;
    const int tid = opaque_tid(), wid = tid >> 6, lane = tid & 63;
    const f32x4 gqv = *(const f32x4*)(gq + lane * 4); const f32x2 gkvv = *(const f32x2*)(gkv + lane * 2);
    for (int tok = opaque_bid() * 8 + wid; tok < TG; tok += gridDim.x * 8) {
        const bf16_t* row = cin + (size_t)tok * 512;
        const u32x2 cq = *(const u32x2*)(row + lane * 4);
        const unsigned ck = *(const unsigned*)(row + 256 + lane * 2);
        const float x = bf2f(row[384 + lane]);
        const float q0 = lo_bf(cq.x), q1 = hi_bf(cq.x), q2 = lo_bf(cq.y), q3 = hi_bf(cq.y), k0 = lo_bf(ck), k1 = hi_bf(ck);
        float ssq = q0 * q0 + q1 * q1 + q2 * q2 + q3 * q3, ssk = k0 * k0 + k1 * k1;
        ssq = wave_sum(ssq); ssk = wave_sum(ssk);
        const float rq = rsqrtf(ssq * (1.0f / 256.0f) + EPS), rk = rsqrtf(ssk * (1.0f / 128.0f) + EPS);
        u32x2 wq; wq.x = cvt_pk_bf16(q0 * rq * gqv[0], q1 * rq * gqv[1]); wq.y = cvt_pk_bf16(q2 * rq * gqv[2], q3 * rq * gqv[3]);
        *(u32x2*)(cn + (size_t)tok * 512 + lane * 4) = wq;
        *(unsigned*)(cn + (size_t)tok * 512 + 256 + lane * 2) = cvt_pk_bf16(k0 * rk * gkvv[0], k1 * rk * gkvv[1]);
        *(unsigned*)(cn + (size_t)tok * 512 + 384 + lane * 2) = 0u;
        const float other = get_xor32(x, lane >> 5);
        const int pos = tok_pos(grp * TG + tok);
        const f32x2 cs = rope[pos * 32 + (lane & 31)];
        const float y = lane < 32 ? (x * cs[0] - other * cs[1]) : (other * cs[1] + x * cs[0]);
        kr[(size_t)tok * 64 + lane] = f2bf(y);
    }
}

namespace att {
constexpr int DQK = 192, DV = 128, NW = 8, QBLK = 32, KVBLK = 64;
constexpr float SCALE = 0.07216878364870322f;
constexpr float THR = 8.f;
constexpr int LDQ = 1536, LDK = 1024, LDKR = 64, LDO = 1024;
constexpr int SHM_V = KVBLK * DV * 2, SHM_K = KVBLK * DQK * 2, SHM_ATTN = 3 * SHM_V + 3 * SHM_K + NW * 64 * 4;
static_assert(SHM_ATTN <= LDS_MAIN, "attention LDS");
#define KSWZ(row, colB) ((row) * 384 + ((colB) ^ ((((row) >> 1) & 7) << 4)))
#define SBAR() __builtin_amdgcn_sched_barrier(0)
__device__ __forceinline__ int crow(int r, int hi) { return (r & 3) + 8 * (r >> 2) + 4 * hi; }
__device__ __forceinline__ void partialSM(f32x16& p0, f32x16& p1, float& m_reg, float& mn, float& alpha) {
    constexpr float C = SCALE * 1.4426950408889634f;
    float pmax = p0[0];
#pragma unroll
    for (int r = 1; r < 16; ++r) pmax = fmaxf(pmax, p0[r]);
#pragma unroll
    for (int r = 0; r < 16; ++r) pmax = fmaxf(pmax, p1[r]);
    { auto rr = __builtin_amdgcn_permlane32_swap(__float_as_uint(pmax), __float_as_uint(pmax), false, false);
      pmax = fmaxf(__uint_as_float(rr[0]), __uint_as_float(rr[1])); }
    if (__builtin_expect(__all(pmax - m_reg <= THR / SCALE), 1)) { mn = m_reg; alpha = 1.f; }
    else { mn = fmaxf(m_reg, pmax); alpha = __builtin_amdgcn_exp2f((m_reg - mn) * C); m_reg = mn; }
    const float mnC = -mn * C;
#pragma unroll
    for (int r = 0; r < 16; ++r) p0[r] = fmaf(p0[r], C, mnC);
#pragma unroll
    for (int r = 0; r < 16; ++r) p1[r] = fmaf(p1[r], C, mnC);
#pragma unroll
    for (int r = 0; r < 16; ++r) p0[r] = __builtin_amdgcn_exp2f(p0[r]);
}
__device__ __forceinline__ void finishSM(f32x16& p0, f32x16& p1, float alpha, float& l_reg, bf16x8& pa0, bf16x8& pa1, bf16x8& pa2, bf16x8& pa3) {
#pragma unroll
    for (int r = 0; r < 16; ++r) p1[r] = __builtin_amdgcn_exp2f(p1[r]);
    float ps = 0;
#pragma unroll
    for (int r = 0; r < 16; ++r) ps += p0[r];
#pragma unroll
    for (int r = 0; r < 16; ++r) ps += p1[r];
    { auto rr = __builtin_amdgcn_permlane32_swap(__float_as_uint(ps), __float_as_uint(ps), false, false);
      ps = __uint_as_float(rr[0]) + __uint_as_float(rr[1]); }
    l_reg = l_reg * alpha + ps;
#define PK4(P, BASE, OUT) do { unsigned a0 = cvt_pk_bf16(P[BASE + 0], P[BASE + 1]), a1 = cvt_pk_bf16(P[BASE + 2], P[BASE + 3]);   \
    unsigned b0 = cvt_pk_bf16(P[BASE + 4], P[BASE + 5]), b1 = cvt_pk_bf16(P[BASE + 6], P[BASE + 7]);                              \
    auto r0 = __builtin_amdgcn_permlane32_swap(a0, b0, false, false); auto r1 = __builtin_amdgcn_permlane32_swap(a1, b1, false, false); \
    u32x4 w = {r0[0], r1[0], r0[1], r1[1]}; OUT = *reinterpret_cast<bf16x8*>(&w); } while (0)
    PK4(p0, 0, pa0); PK4(p0, 8, pa1); PK4(p1, 0, pa2); PK4(p1, 8, pa3);
#undef PK4
}
__device__ __forceinline__ void qkt(f32x16& p0, f32x16& p1, const char* Ks, const bf16x8* qr, int r32, int hi) {
    p0 = f32x16{}; p1 = f32x16{};
#pragma unroll
    for (int d0 = 0; d0 < 12; ++d0) { const int cb = (d0 * 16 + hi * 8) * 2;
        const bf16x8 b0 = *reinterpret_cast<const bf16x8*>(Ks + KSWZ(r32, cb));
        const bf16x8 b1 = *reinterpret_cast<const bf16x8*>(Ks + KSWZ(32 + r32, cb));
        p0 = __builtin_amdgcn_mfma_f32_32x32x16_bf16(b0, qr[d0], p0, 0, 0, 0);
        p1 = __builtin_amdgcn_mfma_f32_32x32x16_bf16(b1, qr[d0], p1, 0, 0, 0); }
}
__device__ __forceinline__ int v_st(int k, int c) { const int kk = (k & ~0xC) | ((k & 4) << 1) | ((k & 8) >> 1); return ((kk >> 3) * 4 + (c >> 5)) * 512 + ((kk & 7) * 32 + (c & 31)) * 2; }
__device__ __forceinline__ int v_rd_base(int lane) { return ((lane & 3) << 3) | (((lane >> 2) & 3) << 6) | (((lane >> 4) & 1) << 5) | (((lane >> 5) & 1) << 8); }
constexpr int v_rd_off(int d0, int ks, int half) { return d0 * 512 + ks * 4096 + half * 2048; }
template <int OFF> __device__ __forceinline__ s16x4 tr_read(int vb) {
    s16x4 r; asm volatile("ds_read_b64_tr_b16 %0, %1 offset:%2" : "=&v"(r) : "v"(vb), "i"(OFF) : "memory"); return r;
}
template <int D0> __device__ __forceinline__ void pv_one(f32x16& od, int vb, bf16x8 pa0, bf16x8 pa1, bf16x8 pa2, bf16x8 pa3) {
    const s16x4 l0 = tr_read<v_rd_off(D0, 0, 0)>(vb), h0 = tr_read<v_rd_off(D0, 0, 1)>(vb), l1 = tr_read<v_rd_off(D0, 1, 0)>(vb), h1 = tr_read<v_rd_off(D0, 1, 1)>(vb);
    const s16x4 l2 = tr_read<v_rd_off(D0, 2, 0)>(vb), h2 = tr_read<v_rd_off(D0, 2, 1)>(vb), l3 = tr_read<v_rd_off(D0, 3, 0)>(vb), h3 = tr_read<v_rd_off(D0, 3, 1)>(vb);
    asm volatile("s_waitcnt lgkmcnt(0)" ::: "memory"); SBAR();
#define PK(L, H) (bf16x8){L[0], L[1], L[2], L[3], H[0], H[1], H[2], H[3]}
    od = __builtin_amdgcn_mfma_f32_32x32x16_bf16(PK(l0, h0), pa0, od, 0, 0, 0);
    od = __builtin_amdgcn_mfma_f32_32x32x16_bf16(PK(l1, h1), pa1, od, 0, 0, 0);
    od = __builtin_amdgcn_mfma_f32_32x32x16_bf16(PK(l2, h2), pa2, od, 0, 0, 0);
    od = __builtin_amdgcn_mfma_f32_32x32x16_bf16(PK(l3, h3), pa3, od, 0, 0, 0);
#undef PK
}
__device__ __forceinline__ void pv_d0(f32x16* o, int vb, bf16x8 pa0, bf16x8 pa1, bf16x8 pa2, bf16x8 pa3) {
    pv_one<0>(o[0], vb, pa0, pa1, pa2, pa3); pv_one<1>(o[1], vb, pa0, pa1, pa2, pa3); pv_one<2>(o[2], vb, pa0, pa1, pa2, pa3); pv_one<3>(o[3], vb, pa0, pa1, pa2, pa3);
}

__device__ __forceinline__ void body(const bf16_t* __restrict__ Qb, const bf16_t* __restrict__ Kn, const bf16_t* __restrict__ Kr, const bf16_t* __restrict__ Vh,
                                     bf16_t* __restrict__ Ob, int seq, int pos0, const f32x2* __restrict__ rope, char* lds, LAS unsigned char* ldsl) {
    const int tid = opaque_tid(), wid = tid >> 6, lane = tid & 63, r32 = lane & 31, hi = lane >> 5;
    char* V_lds = lds; char* K_lds = lds + 3 * SHM_V;
    float* ws = (float*)(lds + 3 * SHM_V + 3 * SHM_K) + wid * 64; float* li_l = ws; float* al_l = ws + 32;
    float m_reg = -1e30f, l_reg = 0; f32x16 o[4] = {}; bf16x8 qr[12];
    const bf16_t* Qw = Qb + (size_t)(wid * QBLK + r32) * LDQ + hi * 8;
#pragma unroll
    for (int d0 = 0; d0 < 12; ++d0) qr[d0] = *reinterpret_cast<const bf16x8*>(Qw + d0 * 16);
    {
        const f32x2* rp = rope + (size_t)(pos0 + wid * QBLK + r32) * 32;
#pragma unroll
        for (int dd = 0; dd < 2; ++dd) {
            bf16x8 x1 = qr[8 + dd], x2 = qr[10 + dd];
#pragma unroll
            for (int e = 0; e < 8; ++e) {
                const f32x2 cs = rp[dd * 16 + hi * 8 + e];
                const float a = bf2f((bf16_t)x1[e]), b = bf2f((bf16_t)x2[e]);
                x1[e] = (short)f2bf(a * cs[0] - b * cs[1]); x2[e] = (short)f2bf(a * cs[1] + b * cs[0]);
            }
            qr[8 + dd] = x1; qr[10 + dd] = x2;
        }
    }
    const int vb0 = (int)(uintptr_t)V_lds + v_rd_base(lane);
    const unsigned wbase = (unsigned)__builtin_amdgcn_readfirstlane(wid) * 1024u;
    const bf16_t* ksrc[3]; int kstr[3]; const bf16_t* vsrc[2];
#pragma unroll
    for (int pc = 0; pc < 3; ++pc) { const int bb = pc * 8192 + tid * 16, row = bb / 384, cB = (bb % 384) ^ ((((row >> 1) & 7)) << 4);
        if (cB < 256) { ksrc[pc] = Kn + (size_t)row * LDK + (cB >> 1); kstr[pc] = LDK; } else { ksrc[pc] = Kr + (size_t)row * LDKR + ((cB - 256) >> 1); kstr[pc] = LDKR; } }
#pragma unroll
    for (int pc = 0; pc < 2; ++pc) { const int bb = pc * 8192 + tid * 16, sub = bb >> 9, within = (bb & 511) >> 1, kk = (sub >> 2) * 8 + (within >> 5), c = (sub & 3) * 32 + (within & 31);
        const int k = (kk & ~0xC) | ((kk & 4) << 1) | ((kk & 8) >> 1); vsrc[pc] = Vh + (size_t)k * LDK + c; }
#define KDMA(b, k0) do { _Pragma("unroll") for (int _p = 0; _p < 3; ++_p) __builtin_amdgcn_global_load_lds((const unsigned*)(ksrc[_p] + (size_t)(k0) * kstr[_p]), \
        (LAS unsigned*)(ldsl + 3 * SHM_V + (b) * SHM_K + _p * 8192 + wbase), 16, 0, 0); } while (0)
#define VDMA(b, k0) do { _Pragma("unroll") for (int _p = 0; _p < 2; ++_p) __builtin_amdgcn_global_load_lds((const unsigned*)(vsrc[_p] + (size_t)(k0) * LDK), \
        (LAS unsigned*)(ldsl + (b) * SHM_V + _p * 8192 + wbase), 16, 0, 0); } while (0)
#define ABAR() do { asm volatile("s_waitcnt lgkmcnt(0)" ::: "memory"); __builtin_amdgcn_s_barrier(); asm volatile("" ::: "memory"); } while (0)
#define AWAIT(full) do { if (full) asm volatile("s_waitcnt vmcnt(5)" ::: "memory"); else asm volatile("s_waitcnt vmcnt(0)" ::: "memory"); } while (0)
#define RESC(a) do { if (__any((a) < 1.f)) { \
    _Pragma("unroll") for (int d = 0; d < 4; ++d) _Pragma("unroll") for (int r = 0; r < 16; ++r) o[d][r] *= (a); } } while (0)
    f32x16 pA0, pA1, pB0, pB1; float mnA, mnB, alA, alB; bf16x8 pa0, pa1, pa2, pa3; const int NT = seq / KVBLK;
    KDMA(0, 0); VDMA(0, 0); KDMA(1, KVBLK); KDMA(2, 2 * KVBLK); VDMA(1, KVBLK);
    asm volatile("s_waitcnt vmcnt(5)" ::: "memory"); ABAR();
    qkt(pA0, pA1, K_lds, qr, r32, hi); partialSM(pA0, pA1, m_reg, mnA, alA);
    ABAR();
    int bp = 0, bc = 1, bn = 2;
    for (int j = 1; j + 1 < NT; j += 2) {
        { const bool k2 = j + 2 < NT;
          if (k2) KDMA(bp, (j + 2) * KVBLK);
          VDMA(bn, (j + 1) * KVBLK);
          SBAR(); qkt(pB0, pB1, K_lds + bc * SHM_K, qr, r32, hi);
          finishSM(pA0, pA1, alA, l_reg, pa0, pa1, pa2, pa3); SBAR();
          pv_d0(o, vb0 + bp * SHM_V, pa0, pa1, pa2, pa3); partialSM(pB0, pB1, m_reg, mnB, alB);
          RESC(alB);
          AWAIT(k2); ABAR();
          const int t = bp; bp = bc; bc = bn; bn = t; }
        { const int jj = j + 1; const bool k2 = jj + 2 < NT;
          if (k2) KDMA(bp, (jj + 2) * KVBLK);
          VDMA(bn, (jj + 1) * KVBLK);
          SBAR(); qkt(pA0, pA1, K_lds + bc * SHM_K, qr, r32, hi);
          finishSM(pB0, pB1, alB, l_reg, pa0, pa1, pa2, pa3); SBAR();
          pv_d0(o, vb0 + bp * SHM_V, pa0, pa1, pa2, pa3); partialSM(pA0, pA1, m_reg, mnA, alA);
          RESC(alA);
          AWAIT(k2); ABAR();
          const int t = bp; bp = bc; bc = bn; bn = t; }
    }
    SBAR(); qkt(pB0, pB1, K_lds + bc * SHM_K, qr, r32, hi);
    finishSM(pA0, pA1, alA, l_reg, pa0, pa1, pa2, pa3); SBAR();
    pv_d0(o, vb0 + bp * SHM_V, pa0, pa1, pa2, pa3); partialSM(pB0, pB1, m_reg, mnB, alB);
    RESC(alB);
    finishSM(pB0, pB1, alB, l_reg, pa0, pa1, pa2, pa3); SBAR();
    pv_d0(o, vb0 + bc * SHM_V, pa0, pa1, pa2, pa3);
    {
        const float rl = __builtin_amdgcn_rcpf(l_reg);
        bf16_t* Ow = Ob + (size_t)(wid * QBLK + r32) * LDO + 4 * hi;
#pragma unroll
        for (int d0 = 0; d0 < 4; ++d0)
#pragma unroll
            for (int g = 0; g < 4; ++g) { u32x2 w; w.x = cvt_pk_bf16(o[d0][4 * g] * rl, o[d0][4 * g + 1] * rl); w.y = cvt_pk_bf16(o[d0][4 * g + 2] * rl, o[d0][4 * g + 3] * rl);
                *(u32x2*)(Ow + d0 * 32 + 8 * g) = w; }
    }
#undef KDMA
#undef VDMA
#undef ABAR
#undef AWAIT
#undef RESC
}
}


namespace gla {
#define KSWZ0(row, colB) ((row) * 256 + ((colB) ^ (((row) & 7) << 4)))
constexpr int L_Q = 0, L_K = 16384, L_V = 32768, L_B = 49152, L_ST = 81920, L_TOT = 114688, L_DEC = 115712;
#define GPK(L, H) (bf16x8){L[0], L[1], L[2], L[3], H[0], H[1], H[2], H[3]}
#define LDS_BARRIER() do { asm volatile("s_waitcnt lgkmcnt(0)" ::: "memory"); __builtin_amdgcn_s_barrier(); asm volatile("" ::: "memory"); } while (0)
__device__ __forceinline__ void phase(const Params& p, int j, int grp, unsigned char* shm) {
    using att::crow; using att::v_st; using att::v_rd_base; using att::v_rd_off; using att::tr_read;
    char* lds = (char*)shm;
    const bf16_t* proj = (const bf16_t*)(p.ws + OFF_ACT + GLA_PROJ);
    bf16_t* of = (bf16_t*)(p.ws + OFF_ACT + GLA_OF);
    bf16_t* ob = (bf16_t*)(p.ws + OFF_ACT + GLA_OB);
    const float* wup_all = p.in[11] + (size_t)j * 2 * 16 * 512;
    const float* bg_all = p.in[12] + (size_t)j * 2 * 512;
    const int tid = opaque_tid(), wid = __builtin_amdgcn_readfirstlane(tid >> 6), lane = tid & 63, r32 = lane & 31, hi = lane >> 5;
    const int ib = wid & 1, wq = wid >> 1;
    const int sr = tid >> 4, sc = (tid & 15) * 8, vst0 = v_st(sr, sc), vst1 = v_st(32 + sr, sc);
    float* tot = (float*)(lds + L_TOT); float* decay = (float*)(lds + L_DEC); float* Bt = (float*)(lds + L_B);
    const int nseq = grp == 0 ? 12 : 8, items = nseq * 16;
    for (int it = opaque_bid(); it < items; it += gridDim.x) {
        const int sl = (nseq - 1) - it / 16, rem = it % 16, h = rem >> 2, dir = (rem >> 1) & 1, dvh = rem & 1;
        int start, len;
        if (grp == 0 || sl < 4) { start = sl * 4096; len = 4096; } else { start = 16384 + (sl - 4) * 8192; len = 8192; }
        const int dcol = 32 * wq + r32;
        bf16x8 wf;
#pragma unroll
        for (int e = 0; e < 8; ++e) wf[e] = (short)f2bf(wup_all[(size_t)(dir * 16 + 8 * hi + e) * 512 + h * 128 + dcol]);
        const float bias_d = bg_all[dir * 512 + h * 128 + dcol];
        for (int i = tid; i < 2048; i += 512) *(u32x4*)(lds + L_ST + i * 16) = (u32x4){0u, 0u, 0u, 0u};
        f32x16 S0 = {}, S1 = {};
        bf16_t* odst = (dir ? ob : of) + h * 256 + dvh * 128;
        const bf16_t* qsrc = proj + h * 128 + sc;
        const bf16_t* ksrc = proj + 512 + h * 128 + sc;
        const bf16_t* vsrc = proj + 1024 + h * 256 + dvh * 128 + sc;
        const bf16_t* asrc = proj + 3072 + dir * 16 + 8 * hi;
        bf16x8 rq0, rq1, rk0, rk1, rv0, rv1, ra;
#define GLA_TOK(step) (start + (dir ? (len - 1 - (step)) : (step)))
#define GLA_LOAD(c) do { const size_t ta = (size_t)GLA_TOK((c) * 64 + sr) * 3328, tb = (size_t)GLA_TOK((c) * 64 + 32 + sr) * 3328; \
        rq0 = *(const bf16x8*)(qsrc + ta); rq1 = *(const bf16x8*)(qsrc + tb); rk0 = *(const bf16x8*)(ksrc + ta); rk1 = *(const bf16x8*)(ksrc + tb); \
        rv0 = *(const bf16x8*)(vsrc + ta); rv1 = *(const bf16x8*)(vsrc + tb); ra = *(const bf16x8*)(asrc + (size_t)GLA_TOK((c) * 64 + 32 * ib + r32) * 3328); } while (0)
        GLA_LOAD(0);
        __syncthreads();
        const int nch = len / 64;
        for (int c = 0; c < nch; ++c) {
            *(bf16x8*)(lds + L_V + vst0) = rv0; *(bf16x8*)(lds + L_V + vst1) = rv1;
            const bf16x8 cq0 = rq0, cq1 = rq1, ck0 = rk0, ck1 = rk1, af = ra;
            if (c + 1 < nch) GLA_LOAD(c + 1);
            {
                f32x16 z;
#pragma unroll
                for (int r = 0; r < 16; ++r) z[r] = bias_d;
                z = __builtin_amdgcn_mfma_f32_32x32x16_bf16(af, wf, z, 0, 0, 0);
                float la[16], tg[4], ug[4];
#pragma unroll
                for (int r = 0; r < 16; ++r) { const float zz = z[r] * 1.4426950408889634f;
                    la[r] = (fminf(zz, 0.f) - __builtin_amdgcn_logf(1.0f + __builtin_amdgcn_exp2f(-fabsf(zz)))) * 0.0625f; }
#pragma unroll
                for (int g = 0; g < 4; ++g) { tg[g] = (la[4 * g] + la[4 * g + 1]) + (la[4 * g + 2] + la[4 * g + 3]); ug[g] = get_xor32(tg[g], hi); }
                float run0 = 0.f;
#pragma unroll
                for (int g = 0; g < 4; ++g) {
                    float run = run0 + (hi ? ug[g] : 0.f);
#pragma unroll
                    for (int e = 0; e < 4; ++e) { run += la[4 * g + e]; Bt[(32 * ib + 8 * g + 4 * hi + e) * 128 + dcol] = run; }
                    run0 += tg[g] + ug[g];
                }
                if (hi == 0) tot[ib * 128 + dcol] = run0;
            }
            LDS_BARRIER();
            {
                const f32x4 t0a = *(const f32x4*)(tot + sc), t0b = *(const f32x4*)(tot + sc + 4);
                const f32x4 b0a = *(const f32x4*)(Bt + sr * 128 + sc), b0b = *(const f32x4*)(Bt + sr * 128 + sc + 4);
                const f32x4 b1a = *(const f32x4*)(Bt + (32 + sr) * 128 + sc) + t0a, b1b = *(const f32x4*)(Bt + (32 + sr) * 128 + sc + 4) + t0b;
                if (tid < 128) decay[tid] = __builtin_amdgcn_exp2f(tot[tid] + tot[128 + tid]);
                u32x4 qo0, ko0, qo1, ko1;
#define GLA_CVT(QO, KO, CQ, CK, BA, BB) do { const u32x4 _q = *reinterpret_cast<const u32x4*>(&CQ), _k = *reinterpret_cast<const u32x4*>(&CK); \
        _Pragma("unroll") for (int _w = 0; _w < 4; ++_w) { const float _b0 = _w < 2 ? BA[2 * _w] : BB[2 * _w - 4], _b1 = _w < 2 ? BA[2 * _w + 1] : BB[2 * _w - 3]; \
            const float _e0 = __builtin_amdgcn_exp2f(_b0), _e1 = __builtin_amdgcn_exp2f(_b1), _n0 = __builtin_amdgcn_exp2f(-_b0), _n1 = __builtin_amdgcn_exp2f(-_b1); \
            QO[_w] = cvt_pk_bf16(lo_bf(_q[_w]) * 0.08838834764831845f * _e0, hi_bf(_q[_w]) * 0.08838834764831845f * _e1); \
            KO[_w] = cvt_pk_bf16(lo_bf(_k[_w]) * _n0, hi_bf(_k[_w]) * _n1); } } while (0)
                GLA_CVT(qo0, ko0, cq0, ck0, b0a, b0b);
                GLA_CVT(qo1, ko1, cq1, ck1, b1a, b1b);
#undef GLA_CVT
                *(u32x4*)(lds + L_Q + KSWZ0(sr, sc * 2)) = qo0; *(u32x4*)(lds + L_Q + KSWZ0(32 + sr, sc * 2)) = qo1;
                *(u32x4*)(lds + L_K + vst0) = ko0; *(u32x4*)(lds + L_K + vst1) = ko1;
            }
            LDS_BARRIER();
            {
                bf16x8 qf[8];
#pragma unroll
                for (int d0 = 0; d0 < 8; ++d0) qf[d0] = *(const bf16x8*)(lds + L_Q + KSWZ0(32 * ib + r32, (d0 * 16 + hi * 8) * 2));
                f32x16 p0 = {}, p1 = {};
#pragma unroll
                for (int d0 = 0; d0 < 8; ++d0) { const bf16x8 kf = *(const bf16x8*)(lds + L_K + v_st(r32, d0 * 16 + hi * 8));
                    p0 = __builtin_amdgcn_mfma_f32_32x32x16_bf16(kf, qf[d0], p0, 0, 0, 0); }
                if (ib) {
#pragma unroll
                    for (int d0 = 0; d0 < 8; ++d0) { const bf16x8 kf = *(const bf16x8*)(lds + L_K + v_st(32 + r32, d0 * 16 + hi * 8));
                        p1 = __builtin_amdgcn_mfma_f32_32x32x16_bf16(kf, qf[d0], p1, 0, 0, 0); }
                }
#pragma unroll
                for (int r = 0; r < 16; ++r) { const bool keep = crow(r, hi) <= r32;
                    if (ib == 0) p0[r] = keep ? p0[r] : 0.f; else p1[r] = keep ? p1[r] : 0.f; }
                bf16x8 pa0, pa1, pa2, pa3;
#define GPK4(P, BASE, OUT) do { unsigned a0 = cvt_pk_bf16(P[BASE + 0], P[BASE + 1]), a1 = cvt_pk_bf16(P[BASE + 2], P[BASE + 3]);   \
    unsigned b0 = cvt_pk_bf16(P[BASE + 4], P[BASE + 5]), b1 = cvt_pk_bf16(P[BASE + 6], P[BASE + 7]);                              \
    auto r0 = __builtin_amdgcn_permlane32_swap(a0, b0, false, false); auto r1 = __builtin_amdgcn_permlane32_swap(a1, b1, false, false); \
    u32x4 w = {r0[0], r1[0], r0[1], r1[1]}; OUT = *reinterpret_cast<bf16x8*>(&w); } while (0)
                GPK4(p0, 0, pa0); GPK4(p0, 8, pa1); GPK4(p1, 0, pa2); GPK4(p1, 8, pa3);
#undef GPK4
                f32x16 o = {};
#pragma unroll
                for (int d0 = 0; d0 < 8; ++d0) { const bf16x8 sf = *(const bf16x8*)(lds + L_ST + KSWZ0(32 * wq + r32, (d0 * 16 + hi * 8) * 2));
                    o = __builtin_amdgcn_mfma_f32_32x32x16_bf16(sf, qf[d0], o, 0, 0, 0); }
                {
                    const int vbase = (int)(uintptr_t)(lds + L_V) + v_rd_base(lane) + wq * 512;
                    const s16x4 l0 = tr_read<v_rd_off(0, 0, 0)>(vbase), h0 = tr_read<v_rd_off(0, 0, 1)>(vbase), l1 = tr_read<v_rd_off(0, 1, 0)>(vbase), h1 = tr_read<v_rd_off(0, 1, 1)>(vbase);
                    const s16x4 l2 = tr_read<v_rd_off(0, 2, 0)>(vbase), h2 = tr_read<v_rd_off(0, 2, 1)>(vbase), l3 = tr_read<v_rd_off(0, 3, 0)>(vbase), h3 = tr_read<v_rd_off(0, 3, 1)>(vbase);
                    asm volatile("s_waitcnt lgkmcnt(0)" ::: "memory"); __builtin_amdgcn_sched_barrier(0);
                    o = __builtin_amdgcn_mfma_f32_32x32x16_bf16(GPK(l0, h0), pa0, o, 0, 0, 0);
                    o = __builtin_amdgcn_mfma_f32_32x32x16_bf16(GPK(l1, h1), pa1, o, 0, 0, 0);
                    o = __builtin_amdgcn_mfma_f32_32x32x16_bf16(GPK(l2, h2), pa2, o, 0, 0, 0);
                    o = __builtin_amdgcn_mfma_f32_32x32x16_bf16(GPK(l3, h3), pa3, o, 0, 0, 0);
                }
                {
                    bf16_t* orow = odst + (size_t)GLA_TOK(c * 64 + 32 * ib + r32) * 1024 + 32 * wq + 4 * hi;
#pragma unroll
                    for (int g = 0; g < 4; ++g) { u32x2 w; w.x = cvt_pk_bf16(o[4 * g], o[4 * g + 1]); w.y = cvt_pk_bf16(o[4 * g + 2], o[4 * g + 3]); *(u32x2*)(orow + 8 * g) = w; }
                }
            }
            {
                const int kbase = (int)(uintptr_t)(lds + L_K) + v_rd_base(lane) + wq * 512;
                const int vb0 = (int)(uintptr_t)(lds + L_V) + v_rd_base(lane) + (2 * ib) * 512, vb1 = vb0 + 512;
                const s16x4 kl0 = tr_read<v_rd_off(0, 0, 0)>(kbase), kh0 = tr_read<v_rd_off(0, 0, 1)>(kbase), kl1 = tr_read<v_rd_off(0, 1, 0)>(kbase), kh1 = tr_read<v_rd_off(0, 1, 1)>(kbase);
                const s16x4 kl2 = tr_read<v_rd_off(0, 2, 0)>(kbase), kh2 = tr_read<v_rd_off(0, 2, 1)>(kbase), kl3 = tr_read<v_rd_off(0, 3, 0)>(kbase), kh3 = tr_read<v_rd_off(0, 3, 1)>(kbase);
                const s16x4 al0 = tr_read<v_rd_off(0, 0, 0)>(vb0), ah0 = tr_read<v_rd_off(0, 0, 1)>(vb0), al1 = tr_read<v_rd_off(0, 1, 0)>(vb0), ah1 = tr_read<v_rd_off(0, 1, 1)>(vb0);
                const s16x4 al2 = tr_read<v_rd_off(0, 2, 0)>(vb0), ah2 = tr_read<v_rd_off(0, 2, 1)>(vb0), al3 = tr_read<v_rd_off(0, 3, 0)>(vb0), ah3 = tr_read<v_rd_off(0, 3, 1)>(vb0);
                const s16x4 bl0 = tr_read<v_rd_off(0, 0, 0)>(vb1), bh0 = tr_read<v_rd_off(0, 0, 1)>(vb1), bl1 = tr_read<v_rd_off(0, 1, 0)>(vb1), bh1 = tr_read<v_rd_off(0, 1, 1)>(vb1);
                const s16x4 bl2 = tr_read<v_rd_off(0, 2, 0)>(vb1), bh2 = tr_read<v_rd_off(0, 2, 1)>(vb1), bl3 = tr_read<v_rd_off(0, 3, 0)>(vb1), bh3 = tr_read<v_rd_off(0, 3, 1)>(vb1);
                float dk[16];
#pragma unroll
                for (int r = 0; r < 16; ++r) dk[r] = decay[32 * wq + crow(r, hi)];
                asm volatile("s_waitcnt lgkmcnt(0)" ::: "memory"); __builtin_amdgcn_sched_barrier(0);
                S0 = __builtin_amdgcn_mfma_f32_32x32x16_bf16(GPK(kl0, kh0), GPK(al0, ah0), S0, 0, 0, 0);
                S1 = __builtin_amdgcn_mfma_f32_32x32x16_bf16(GPK(kl0, kh0), GPK(bl0, bh0), S1, 0, 0, 0);
                S0 = __builtin_amdgcn_mfma_f32_32x32x16_bf16(GPK(kl1, kh1), GPK(al1, ah1), S0, 0, 0, 0);
                S1 = __builtin_amdgcn_mfma_f32_32x32x16_bf16(GPK(kl1, kh1), GPK(bl1, bh1), S1, 0, 0, 0);
                S0 = __builtin_amdgcn_mfma_f32_32x32x16_bf16(GPK(kl2, kh2), GPK(al2, ah2), S0, 0, 0, 0);
                S1 = __builtin_amdgcn_mfma_f32_32x32x16_bf16(GPK(kl2, kh2), GPK(bl2, bh2), S1, 0, 0, 0);
                S0 = __builtin_amdgcn_mfma_f32_32x32x16_bf16(GPK(kl3, kh3), GPK(al3, ah3), S0, 0, 0, 0);
                S1 = __builtin_amdgcn_mfma_f32_32x32x16_bf16(GPK(kl3, kh3), GPK(bl3, bh3), S1, 0, 0, 0);
#pragma unroll
                for (int r = 0; r < 16; ++r) { S0[r] *= dk[r]; S1[r] *= dk[r]; }
            }
            LDS_BARRIER();
#pragma unroll
            for (int g = 0; g < 4; ++g) {
                const int d0 = 32 * wq + 8 * g + 4 * hi;
                u32x2 w0; w0.x = cvt_pk_bf16(S0[4 * g], S0[4 * g + 1]); w0.y = cvt_pk_bf16(S0[4 * g + 2], S0[4 * g + 3]);
                u32x2 w1; w1.x = cvt_pk_bf16(S1[4 * g], S1[4 * g + 1]); w1.y = cvt_pk_bf16(S1[4 * g + 2], S1[4 * g + 3]);
                *(u32x2*)(lds + L_ST + KSWZ0(64 * ib + r32, 2 * d0)) = w0;
                *(u32x2*)(lds + L_ST + KSWZ0(64 * ib + 32 + r32, 2 * d0)) = w1;
            }
        }
        __syncthreads();
#undef GLA_LOAD
#undef GLA_TOK
    }
}
}

__device__ __forceinline__ void phase_mla_attn(const Params& p, int grp, unsigned char* shm) {
    const bf16_t* Q = (const bf16_t*)(p.ws + OFF_ACT + MLA_Q);
    const bf16_t* Kn = (const bf16_t*)(p.ws + OFF_ACT + MLA_KN);
    const bf16_t* Kr = (const bf16_t*)(p.ws + OFF_ACT + MLA_KR);
    const bf16_t* V = (const bf16_t*)(p.ws + OFF_ACT + MLA_V);
    bf16_t* O = (bf16_t*)(p.ws + OFF_ACT + MLA_O);
    const f32x2* rope = (const f32x2*)(p.ws + OFF_ROPE);
    const int nb = gridDim.x, per = nb >> 3, bid = opaque_bid(), xcd = bid & 7, slot = bid >> 3;
    constexpr int ITEMS = 1536;
    for (int r = 0;; ++r) {
        const int vv = r * nb + xcd * per + slot;
        if (vv >= ITEMS) break;
        int start, len, h, qb;
        if (grp == 0) { const int sl = vv >> 7; h = (vv & 127) >> 4; qb = vv & 15; start = sl * 4096; len = 4096; }
        else if (vv < 1024) { const int sl = vv >> 8; h = (vv & 255) >> 5; qb = vv & 31; start = 16384 + sl * 8192; len = 8192; }
        else { const int v2 = vv - 1024, sl = v2 >> 7; h = (v2 & 127) >> 4; qb = v2 & 15; start = sl * 4096; len = 4096; }
        const size_t q0 = (size_t)(start + qb * 256);
        att::body(Q + q0 * 1536 + h * 192, Kn + (size_t)start * 1024 + h * 128, Kr + (size_t)start * 64, V + (size_t)start * 1024 + h * 128,
                  O + q0 * 1024 + h * 128, len, qb * 256, rope, (char*)shm, (LAS unsigned char*)shm);
        __syncthreads();
    }
}


#define XB_TMO      128
#define XB_XCNT(j)  (256  + 64 * (j))
#define XB_XSUB(j)  (1280 + 64 * (j))
#define XB_XGEN(j)  (2304 + 64 * (j))
#define XB_TOP      3328
#define XB_TOPGEN   3392
#define XCD_BAR_WORDS 3456
#define XB_SPIN_CAP (1u << 23)
__device__ __forceinline__ unsigned xb_ld(unsigned* p)              { return __hip_atomic_load(p, __ATOMIC_RELAXED, __HIP_MEMORY_SCOPE_AGENT); }
__device__ __forceinline__ unsigned xb_add(unsigned* p, unsigned v) { return __hip_atomic_fetch_add(p, v, __ATOMIC_RELAXED, __HIP_MEMORY_SCOPE_AGENT); }
__device__ __forceinline__ unsigned xb_xcc_id() { return (unsigned)__builtin_amdgcn_s_getreg((3 << 11) | 20) & 0xFu; }
#define XB_SPIN(cond, bar) do { unsigned _sp = 0; while (cond) { __builtin_amdgcn_s_sleep(1); \
    if ((++_sp & 255u) == 0u) { if (xb_ld(&(bar)[XB_TMO])) break; if (_sp > XB_SPIN_CAP) { atomicAdd(&(bar)[XB_TMO], 1u); break; } } } } while (0)
__device__ __forceinline__ void xcd_barrier_post(unsigned* bar) { if (opaque_tid() == 0) (void)xb_add(&bar[XB_XCNT(xb_xcc_id())], 1u); }
__device__ __forceinline__ void xcd_barrier_complete(unsigned* bar, unsigned x, unsigned& nloc, unsigned& nx) {
    const unsigned G = gridDim.x;
    unsigned sum, cnt, mine, sp = 0u;
    for (;;) {
        sum = 0u; cnt = 0u; mine = 0u;
#pragma unroll
        for (unsigned j = 0; j < 16; ++j) { const unsigned c = xb_ld(&bar[XB_XCNT(j)]); sum += c; cnt += (c > 0u) ? 1u : 0u; mine = (j == x) ? c : mine; }
        if (sum == G) break;
        __builtin_amdgcn_s_sleep(1);
        if ((++sp & 255u) == 0u) { if (xb_ld(&bar[XB_TMO])) break; if (sp > XB_SPIN_CAP) { atomicAdd(&bar[XB_TMO], 1u); break; } }
    }
    nloc = mine > 0u ? mine : 1u; nx = cnt > 0u ? cnt : 1u;
}
__device__ __forceinline__ void xcd_barrier(unsigned* bar, volatile LAS unsigned* st) {
    asm volatile("s_waitcnt vmcnt(0)" ::: "memory");
    __syncthreads();
    if (opaque_tid() == 0) {
        const unsigned x = xb_xcc_id();
        __builtin_amdgcn_s_waitcnt(0);
        unsigned nloc = st[0], nx = st[1];
        if (nloc == 0u) { xcd_barrier_complete(bar, x, nloc, nx); st[0] = nloc; st[1] = nx; }
        const unsigned old = xb_add(&bar[XB_XSUB(x)], 1u);
        const unsigned gen = old / nloc;
        if (old + 1u == (gen + 1u) * nloc) {
            __builtin_amdgcn_fence(__ATOMIC_RELEASE, "agent");
            asm volatile("s_waitcnt vmcnt(0)" ::: "memory");
            const unsigned og = xb_add(&bar[XB_TOP], 1u);
            const unsigned tg = og / nx;
            if (og + 1u == (tg + 1u) * nx) xb_add(&bar[XB_TOPGEN], 1u);
            else XB_SPIN(xb_ld(&bar[XB_TOPGEN]) == tg, bar);
            __builtin_amdgcn_fence(__ATOMIC_ACQUIRE, "agent");
            xb_add(&bar[XB_XGEN(x)], 1u);
            asm volatile("s_waitcnt vmcnt(0)" ::: "memory");
        } else {
            XB_SPIN(xb_ld(&bar[XB_XGEN(x)]) == gen, bar);
            __builtin_amdgcn_fence(__ATOMIC_ACQUIRE, "agent");
            asm volatile("s_waitcnt vmcnt(0)" ::: "memory");
        }
    }
    __syncthreads();
}

#ifndef PH_MASK
#define PH_MASK 0xFFFFFF
#endif
#define PH(bit) if constexpr ((PH_MASK >> (bit)) & 1)
#ifndef PROBE_DBL
#define PROBE_DBL 0
#endif
#define GSYNC() do { xcd_barrier(xbar, xst); if constexpr ((PROBE_DBL >> 4) & 1) xcd_barrier(xbar, xst); } while (0)
#define DBL(bit) for (int _rep = 0; _rep < (((PROBE_DBL >> (bit)) & 1) ? 2 : 1); ++_rep)
__global__ __launch_bounds__(512, 2) void mega_kernel(Params p) {
    extern __shared__ __attribute__((aligned(16))) unsigned char shm[];
    cg::grid_group grid = cg::this_grid();
    LAS unsigned char* lds = (LAS unsigned char*)shm;
    bf16_t* Wb = (bf16_t*)(p.ws + OFF_W);
    const float* modb = (const float*)(p.ws + OFF_MOD);
    bf16_t* Hb = (bf16_t*)p.out;
    bf16_t* ACT = (bf16_t*)(p.ws + OFF_ACT);
    float* XF = (float*)(p.ws + OFF_H);
    unsigned* xbar = (unsigned*)(p.ws + OFF_BAR);
    volatile LAS unsigned* xst = (volatile LAS unsigned*)(lds + LDS_MAIN);
    if (opaque_tid() == 0) { xst[0] = 0u; xst[1] = 0u; }
    __syncthreads();
    xcd_barrier_post(xbar);

    DBL(5) {
    PH(0) prep_mod(p, shm);
    __syncthreads();
    PH(1) prep_rope(p);
    PH(2) prep_weights(p, shm);
    grid.sync();
    phase_tb(p, shm);
    phase_prenorm(p);
    GSYNC();
    }

    float* ssqb = (float*)(p.ws + OFF_SSQ);
    const float* tball = (const float*)(p.ws + OFF_TB);
#pragma unroll 1
    for (int l = 0; l < 4; ++l) {
        const float* modl = modb + (size_t)l * NSEQ * MODW;
        const int mj = l >> 1;
        const bf16_t* wmix = Wb + W_FFN_TOTAL + (size_t)mj * W_MIX_STRIDE;
#pragma unroll 1
        for (int w = 0; w < 2; ++w) {
            const int inst = 3 * l + (w ? 2 : 0), mi = w ? 6 : 0;
            float* ssq_cur = ssqb + (size_t)(inst & 1) * T_ALL * 16; float* ssq_nxt = ssqb + (size_t)((inst + 1) & 1) * T_ALL * 16;
            const bf16_t* wgu = Wb + (size_t)(l * 2 + w) * W_FFN_STRIDE;
            DBL(1) PH(5) { pg8::EpiGateUp E; E.O = ACT; E.ssq = ssq_cur; E.tb = tball + (size_t)(l * 2 + w) * TB_FFN_SZ; run_gemm(lds, Hb, 1024, wgu, 1024, T_ALL, 5632, 1024, E); }
            GSYNC();
            {
                const bool last = (l == 3 && w == 1);
                const int nl = w ? l + 1 : l;
                const float* gprev = p.in[6] + (size_t)(l * 3 + (w ? 2 : 0)) * 1024; const float* scprev = modl + (mi + 1) * 1024;
                if (last) { pg8::EpiResidLast E; E.XS = Hb; E.gprev = gprev; E.scprev = scprev; E.gate = modl + (mi + 2) * 1024; E.coef = 0.5f; E.lo = XF; E.hi_ = p.out;
                    run_gemm(lds, ACT, DFF, wgu + SZ_GU, DFF, T_ALL, 1024, DFF, E); }
                else { pg8::EpiResid E; E.gate = modl + (mi + 2) * 1024; E.coef = 0.5f; E.tile0 = 0; E.gprev = gprev; E.scprev = scprev;
                    E.XS = Hb; E.gnext = p.in[6] + (size_t)(nl * 3 + (w ? 0 : 1)) * 1024;
                    E.scnext = modb + (size_t)nl * NSEQ * MODW + (w ? 1 : 4) * 1024; E.ssq = ssq_nxt;
                    PH(6) run_gemm(lds, ACT, DFF, wgu + SZ_GU, DFF, T_ALL, 1024, DFF, E); }
            }
            GSYNC();
            if (w == 0) {
                float* ssq_m = ssq_nxt;
                float* ssq_f2 = ssq_cur;
#pragma unroll 1
                for (int grp = 0; grp < 2; ++grp) {
                    const bf16_t* hg = Hb + (size_t)grp * TG * 1024;
                    const int t0 = grp * (TG / 256);
                    if ((l & 1) == 0) {
                        PH(7) { pg8::EpiBf16N E; E.O = (bf16_t*)(p.ws + OFF_ACT + GLA_PROJ); E.ldc = 3328; E.ssq = ssq_m + (size_t)grp * TG * 16; E.tb = tball + 8 * TB_FFN_SZ + (size_t)mj * TB_PROJ_SZ; E.ldtb = 3328; E.tile0 = t0;
                            run_gemm(lds, hg, 1024, wmix, 1024, TG, 3328, 1024, E); }
                        GSYNC();
                        DBL(2) PH(8) gla::phase(p, mj, grp, shm);
                        GSYNC();
                        PH(9) phase_gla_combine(p, mj, grp);
                        GSYNC();
                        PH(13) { pg8::EpiResid E; E.gate = modl + 5 * 1024; E.coef = 1.0f; E.tile0 = t0; E.gprev = p.in[6] + (size_t)(l * 3 + 1) * 1024; E.scprev = modl + 4 * 1024;
                          E.XS = Hb + (size_t)grp * TG * 1024; E.gnext = p.in[6] + (size_t)(l * 3 + 2) * 1024; E.scnext = modl + 7 * 1024; E.ssq = ssq_f2 + (size_t)grp * TG * 16;
                          run_gemm(lds, (const bf16_t*)(p.ws + OFF_ACT + GLA_OF), 1024, wmix + SZ_GIN, 1024, TG, 1024, 1024, E); }
                        GSYNC();
                    } else {
                        const bf16_t* w_min = wmix + SZ_GIN + SZ_GOUT; const bf16_t* w_uq = w_min + SZ_MIN; const bf16_t* w_ukv = w_uq + SZ_UQ; const bf16_t* w_mout = w_ukv + SZ_UKV;
                        PH(14) { pg8::EpiBf16N E; E.O = (bf16_t*)(p.ws + OFF_ACT + MLA_CIN); E.ldc = 512; E.ssq = ssq_m + (size_t)grp * TG * 16; E.tb = tball + 8 * TB_FFN_SZ + 2 * TB_PROJ_SZ + (size_t)mj * TB_CIN_SZ; E.ldtb = 512; E.tile0 = t0;
                            run_gemm(lds, hg, 1024, w_min, 1024, TG, 512, 1024, E); }
                        GSYNC();
                        PH(10) phase_mla_normrope(p, mj, grp);
                        GSYNC();
                        const bf16_t* cn = (const bf16_t*)(p.ws + OFF_ACT + MLA_CN);
                        PH(15) { pg8::EpiBf16 E; E.O = (bf16_t*)(p.ws + OFF_ACT + MLA_Q); E.ldc = 1536; run_gemm(lds, cn, 512, w_uq, 256, TG, 1536, 256, E); }
                        PH(12) { pg8::EpiKV E; E.Kn = (bf16_t*)(p.ws + OFF_ACT + MLA_KN); E.V = (bf16_t*)(p.ws + OFF_ACT + MLA_V); run_gemm(lds, cn + 256, 512, w_ukv, 256, TG, 2048, 256, E); }
                        GSYNC();
                        DBL(0) PH(11) phase_mla_attn(p, grp, shm);
                        GSYNC();
                        PH(16) { pg8::EpiResid E; E.gate = modl + 5 * 1024; E.coef = 1.0f; E.tile0 = t0; E.gprev = p.in[6] + (size_t)(l * 3 + 1) * 1024; E.scprev = modl + 4 * 1024;
                          E.XS = Hb + (size_t)grp * TG * 1024; E.gnext = p.in[6] + (size_t)(l * 3 + 2) * 1024; E.scnext = modl + 7 * 1024; E.ssq = ssq_f2 + (size_t)grp * TG * 16;
                          run_gemm(lds, (const bf16_t*)(p.ws + OFF_ACT + MLA_O), 1024, w_mout, 1024, TG, 1024, 1024, E); }
                        GSYNC();
                    }
                }
            }
        }
    }
    const float* fin = modb + 4ull * NSEQ * MODW;
    phase_final(XF, p.out, p.in[23], fin, fin + 1024, 2048);
}

extern "C" void kernel_launch(void* const* d_in, const int* in_sizes, int n_in, void* d_out, int out_size, void* d_ws, size_t ws_size, hipStream_t stream) {
    static int grid_blocks = 0;
    if (!grid_blocks) {
        if (n_in != 24 || (size_t)out_size != (size_t)T_ALL * 1024 || ws_size < WS_NEED) {
            fprintf(stderr, "kernel_launch: unexpected shapes: n_in %d out %d ws %zu (need %zu)\n", n_in, out_size, ws_size, (size_t)WS_NEED);
            return;
        }
        if (hipFuncSetAttribute((const void*)mega_kernel, hipFuncAttributeMaxDynamicSharedMemorySize, LDS_BYTES) != hipSuccess) { fprintf(stderr, "kernel_launch: LDS attribute failed\n"); return; }
        int dev = 0, cus = 0, per_cu = 0;
        hipGetDevice(&dev);
        hipDeviceGetAttribute(&cus, hipDeviceAttributeMultiprocessorCount, dev);
        hipOccupancyMaxActiveBlocksPerMultiprocessor(&per_cu, mega_kernel, 512, LDS_BYTES);
        if (per_cu < 1) { fprintf(stderr, "kernel_launch: occupancy 0\n"); return; }
        grid_blocks = cus;
    }
    Params p{};
    for (int i = 0; i < 24; ++i) p.in[i] = (const float*)d_in[i];
    p.out = (float*)d_out; p.ws = (unsigned char*)d_ws;
    hipMemsetAsync((unsigned char*)d_ws + OFF_BAR, 0, XCD_BAR_WORDS * sizeof(unsigned), stream);
    void* args[] = {&p};
    hipError_t e = hipLaunchCooperativeKernel((void*)mega_kernel, dim3(grid_blocks), dim3(512), args, LDS_BYTES, stream);
    if (e != hipSuccess) fprintf(stderr, "cooperative launch failed: %s (grid %d)\n", hipGetErrorString(e), grid_blocks);
}
```

```cpp
#include <hip/hip_runtime.h>
#include <hip/hip_cooperative_groups.h>
#include <cstdio>
#include <cstdint>
namespace cg = cooperative_groups;

#define LAS __attribute__((address_space(3)))
typedef unsigned short bf16_t;
typedef short bf16x8 __attribute__((ext_vector_type(8)));
typedef short s16x4 __attribute__((ext_vector_type(4)));
typedef float f32x4 __attribute__((ext_vector_type(4)));
typedef float f32x2 __attribute__((ext_vector_type(2)));
typedef float f32x16 __attribute__((ext_vector_type(16)));
typedef unsigned u32x4 __attribute__((ext_vector_type(4)));
typedef unsigned u32x2 __attribute__((ext_vector_type(2)));

constexpr int T_ALL = 98304, TG = 49152, DM = 1024, DFF = 2816, NSEQ = 20, MODW = 9216;
constexpr float EPS = 1e-6f;
constexpr size_t XP_ELEMS = 16ull * 4096 * 1024;

constexpr size_t SZ_GU = 5632ull * 1024, SZ_DN = 1024ull * 2816, W_FFN_STRIDE = SZ_GU + SZ_DN, W_FFN_TOTAL = 8 * W_FFN_STRIDE;
constexpr size_t SZ_GIN = 3328ull * 1024, SZ_GOUT = 1024ull * 1024, SZ_MIN = 512ull * 1024, SZ_UQ = 1536ull * 256, SZ_UKV = 2048ull * 256, SZ_MOUT = 1024ull * 1024;
constexpr size_t W_MIX_STRIDE = SZ_GIN + SZ_GOUT + SZ_MIN + SZ_UQ + SZ_UKV + SZ_MOUT;
constexpr size_t W_TOTAL = W_FFN_TOTAL + 2 * W_MIX_STRIDE;
constexpr size_t OFF_W = 0;
constexpr size_t OFF_MOD = OFF_W + W_TOTAL * 2;
constexpr size_t MOD_FLOATS = 4ull * NSEQ * MODW + (size_t)NSEQ * 2048;
constexpr size_t OFF_ROPE = OFF_MOD + MOD_FLOATS * 4;
constexpr size_t OFF_H = OFF_ROPE + 8192ull * 32 * 8;
constexpr size_t OFF_ACT = OFF_H + (size_t)T_ALL * 1024 * 2;
constexpr size_t OFF_BAR = OFF_ACT + (size_t)T_ALL * DFF * 2;
constexpr size_t OFF_SSQ = OFF_BAR + 16384;
constexpr size_t OFF_TB = OFF_SSQ + 2ull * T_ALL * 16 * 4;
constexpr size_t TB_FFN_SZ = 20ull * 5632, TB_PROJ_SZ = 20ull * 3328, TB_CIN_SZ = 20ull * 512;
constexpr size_t TB_FLOATS = 8 * TB_FFN_SZ + 2 * TB_PROJ_SZ + 2 * TB_CIN_SZ;
constexpr size_t WS_NEED = OFF_TB + TB_FLOATS * 4;
static_assert(OFF_MOD % 256 == 0 && OFF_ROPE % 256 == 0 && OFF_H % 256 == 0 && OFF_ACT % 256 == 0, "align");
constexpr size_t GLA_PROJ = 0, GLA_OF = GLA_PROJ + (size_t)TG * 3328 * 2, GLA_OB = GLA_OF + (size_t)TG * 1024 * 2, GLA_END = GLA_OB + (size_t)TG * 1024 * 2;
constexpr size_t MLA_O = 0;
constexpr size_t MLA_CIN = 0, MLA_CN = MLA_CIN + (size_t)TG * 512 * 2, MLA_KR = MLA_CN + (size_t)TG * 512 * 2, MLA_Q = MLA_KR + (size_t)TG * 64 * 2,
                 MLA_KN = MLA_Q + (size_t)TG * 1536 * 2, MLA_V = MLA_KN + (size_t)TG * 1024 * 2, MLA_END = MLA_V + (size_t)TG * 1024 * 2;
static_assert(GLA_END <= (size_t)T_ALL * DFF * 2 && MLA_END <= (size_t)T_ALL * DFF * 2, "act region");

constexpr int LDS_MAIN = 131072, LDS_BYTES = LDS_MAIN + 16;

struct Params {
    const float* in[24];
    float* out;
    unsigned char* ws;
};

__device__ __forceinline__ int opaque_tid() { int t = threadIdx.x; asm volatile("" : "+v"(t)); return t; }
__device__ __forceinline__ int opaque_bid() { int b = blockIdx.x; asm volatile("" : "+s"(b)); return b; }
__device__ __forceinline__ float bf2f(bf16_t b) { return __uint_as_float(((unsigned)b) << 16); }
typedef __bf16 bf16v2 __attribute__((ext_vector_type(2)));
__device__ __forceinline__ bf16_t f2bf(float f) { return __builtin_bit_cast(bf16_t, (__bf16)f); }
__device__ __forceinline__ unsigned cvt_pk_bf16(float lo, float hi) { f32x2 v = {lo, hi}; bf16v2 b = __builtin_convertvector(v, bf16v2); return __builtin_bit_cast(unsigned, b); }
template <int M> __device__ __forceinline__ float swz_xor(float x) { return __int_as_float(__builtin_amdgcn_ds_swizzle(__float_as_int(x), (M << 10) | 0x1F)); }
__device__ __forceinline__ float sum_xor32(float x) { auto rr = __builtin_amdgcn_permlane32_swap(__float_as_uint(x), __float_as_uint(x), false, false); return __uint_as_float(rr[0]) + __uint_as_float(rr[1]); }
__device__ __forceinline__ float get_xor32(float x, int hi) { auto rr = __builtin_amdgcn_permlane32_swap(__float_as_uint(x), __float_as_uint(x), false, false); return hi ? __uint_as_float(rr[0]) : __uint_as_float(rr[1]); }
__device__ __forceinline__ float wave_sum(float x) { x += swz_xor<1>(x); x += swz_xor<2>(x); x += swz_xor<4>(x); x += swz_xor<8>(x); x += swz_xor<16>(x); return sum_xor32(x); }
__device__ __forceinline__ int tok_batch(int t) { return t < 65536 ? (t >> 12) : 16 + ((t - 65536) >> 13); }
__device__ __forceinline__ int tok_pos(int t) { return t < 65536 ? (t & 4095) : ((t - 65536) & 8191); }
__device__ __forceinline__ float silu_f(float g) { return g * __builtin_amdgcn_rcpf(1.0f + __expf(-g)); }
__device__ __forceinline__ float lo_bf(unsigned w) { return __uint_as_float(w << 16); }
__device__ __forceinline__ float hi_bf(unsigned w) { return __uint_as_float(w & 0xffff0000u); }

namespace pg8 {
constexpr int BM = 256, BK = 64, HALF = 128, HTB = HALF * BK * 2, STAGE_BYTES = 8 * HTB, NXCD = 8, WGM = 8;
__device__ __forceinline__ int lds_byte(int r, int c) { const int st = (r >> 4) * 2 + (c >> 5), rr = r & 15, cc = c & 31, ob = rr * 64 + cc * 2; return st * 1024 + (ob ^ (((ob >> 9) & 1) << 5)); }
__device__ __forceinline__ void stage_rc(int b, int& R, int& C) { const int st = b / 1024, sb = b % 1024, swz = sb ^ (((sb >> 9) & 1) << 5); R = (st >> 1) * 16 + swz / 64; C = (st & 1) * 32 + (swz % 64) / 2; }
__device__ __forceinline__ int perm32(int rho) { const int n = rho >> 4, i = rho & 15; return 8 * (i >> 2) + 4 * n + (i & 3); }
struct Unit { int pm, pn; };
struct Gemm { const bf16_t* A; const bf16_t* Bt; int M, N, K, lda, ldb; };
struct StaticOrder {
    int nM, nN, nwg, G, c;
    __device__ void init(int M, int N, int G_, int c_) { nM = M / BM; nN = N / BM; nwg = nM * nN; G = G_; c = c_; }
    __device__ bool next(int i, Unit& u) const {
        const long L = (long)i * G + c; if (L >= nwg) return false;
        int wgid = (int)L; { const int q = nwg / NXCD, r = nwg % NXCD, xcd = wgid % NXCD, off = wgid / NXCD; wgid = (xcd < r ? xcd * (q + 1) : r * (q + 1) + (xcd - r) * q) + off; }
        const int nig = WGM * nN, gid = wgid / nig, fm = gid * WGM, gsz = (nM - fm) < WGM ? (nM - fm) : WGM;
        u.pm = fm + ((wgid % nig) % gsz); u.pn = (wgid % nig) / gsz; return true;
    }
};

template <class Epi>
__device__ __forceinline__ void gemm_phase(LAS unsigned char* lds, const Gemm g, const StaticOrder& S, const Epi& E) {
    const int tid = opaque_tid(), wid = __builtin_amdgcn_readfirstlane(tid >> 6), lane = tid & 63, wr = wid >> 2, wc = wid & 3, fr = lane & 15, fq = lane >> 4;
    const int K = g.K, nt = K / BK;
    unsigned voffA[2], voffB[2];
#pragma unroll
    for (int i = 0; i < 2; ++i) { int R, C; stage_rc(tid * 16 + i * 8192, R, C); const int Rb = Epi::PERM ? ((R & ~31) + perm32(R & 31)) : R;
        voffA[i] = (unsigned)(R * g.lda + C) * 2u; voffB[i] = (unsigned)(Rb * g.ldb + C) * 2u; }
    const size_t kstep = (size_t)(BK * 2);
    const size_t hstepA = (size_t)HALF * g.lda * 2, hstepB = (size_t)HALF * g.ldb * 2;
    const size_t tstepA = 2 * hstepA, tstepB = 2 * hstepB;
    const unsigned ldsw = (unsigned)wid * 1024u;
    const int aoff = lds_byte(wr * 64 + fr, fq * 8), boff = lds_byte(wc * 32 + fr, fq * 8);
#define PG8_SA(b, h) (((b) * 2 + (h)) * HTB)
#define PG8_SB(b, h) ((4 + (b) * 2 + (h)) * HTB)
#define PG8_STAGE(bufoff, gbase, voff) do { _Pragma("unroll") for (int _i = 0; _i < 2; ++_i) \
        __builtin_amdgcn_global_load_lds((const unsigned*)((const char*)(gbase) + (voff)[_i]), (LAS unsigned*)(lds + (bufoff) + ldsw + _i * 8192), 16, 0, 0); } while (0)
#define PG8_LDA(dst, b, h) do { _Pragma("unroll") for (int m = 0; m < 4; ++m) _Pragma("unroll") for (int k = 0; k < 2; ++k) dst[m][k] = *(const LAS bf16x8*)(lds + PG8_SA(b, h) + aoff + m * 2048 + k * 1024); } while (0)
#define PG8_LDB(dst, b, h) do { _Pragma("unroll") for (int n = 0; n < 2; ++n) _Pragma("unroll") for (int k = 0; k < 2; ++k) dst[n][k] = *(const LAS bf16x8*)(lds + PG8_SB(b, h) + boff + n * 2048 + k * 1024); } while (0)
#define PG8_MMA(ai, bj, At, Bt) do { __builtin_amdgcn_s_setprio(1); _Pragma("unroll") for (int m = 0; m < 4; ++m) _Pragma("unroll") for (int n = 0; n < 2; ++n) _Pragma("unroll") for (int k = 0; k < 2; ++k) \
        acc[ai][bj][m][n] = __builtin_amdgcn_mfma_f32_16x16x32_bf16(Bt[n][k], At[m][k], acc[ai][bj][m][n], 0, 0, 0); __builtin_amdgcn_s_setprio(0); } while (0)
#define PG8_WAIT_V(n) asm volatile("s_waitcnt vmcnt(" #n ")" ::: "memory")
#define PG8_WAIT_L(n) asm volatile("s_waitcnt lgkmcnt(" #n ")" ::: "memory")
#define PG8_BAR __builtin_amdgcn_s_barrier()
#define PG8_SCHED __builtin_amdgcn_sched_barrier(0)
    Unit cur, nxt; int ui = 0;
    if (!S.next(0, cur)) return;
    f32x4 acc[2][2][4][2];
#pragma unroll
    for (int a = 0; a < 2; ++a)
#pragma unroll
        for (int b = 0; b < 2; ++b)
#pragma unroll
            for (int m = 0; m < 4; ++m)
#pragma unroll
                for (int n = 0; n < 2; ++n) acc[a][b][m][n] = (f32x4){0.f, 0.f, 0.f, 0.f};
    bf16x8 At[4][2], B0[2][2], B1[2][2];
    const char* cA = (const char*)g.A + (size_t)cur.pm * tstepA; const char* cB = (const char*)g.Bt + (size_t)cur.pn * tstepB;
    PG8_STAGE(PG8_SB(0, 0), cB, voffB); PG8_STAGE(PG8_SA(0, 0), cA, voffA); PG8_STAGE(PG8_SB(0, 1), cB + hstepB, voffB); PG8_STAGE(PG8_SA(0, 1), cA + hstepA, voffA);
    if (wr == 1) PG8_BAR;
    PG8_WAIT_V(4); PG8_BAR;
    PG8_STAGE(PG8_SB(1, 0), cB + kstep, voffB); PG8_STAGE(PG8_SA(1, 0), cA + kstep, voffA); PG8_STAGE(PG8_SB(1, 1), cB + hstepB + kstep, voffB);
    PG8_WAIT_V(6); PG8_BAR;
    for (;;) {
        const bool has_next = S.next(ui + 1, nxt);
        const char* nA = has_next ? (const char*)g.A + (size_t)nxt.pm * tstepA : cA; const char* nB = has_next ? (const char*)g.Bt + (size_t)nxt.pn * tstepB : cB;
#pragma unroll 1
        for (int t = 0; t < nt; t += 2) {
            const bool last = (t == nt - 2);
            const char* a1 = cA + (size_t)(t + 1) * kstep;
            const char* a2 = last ? nA : cA + (size_t)(t + 2) * kstep; const char* b2 = last ? nB : cB + (size_t)(t + 2) * kstep;
            const char* a3 = a2 + kstep; const char* b3 = b2 + kstep;
            PG8_LDB(B0, 0, 0); PG8_SCHED; PG8_LDA(At, 0, 0); PG8_STAGE(PG8_SA(1, 1), a1 + hstepA, voffA);
            PG8_WAIT_L(8); PG8_BAR; PG8_WAIT_L(0); PG8_MMA(0, 0, At, B0); PG8_BAR; PG8_SCHED;
            PG8_LDB(B1, 0, 1); PG8_STAGE(PG8_SB(0, 0), b2, voffB);
            PG8_BAR; PG8_WAIT_L(0); PG8_MMA(0, 1, At, B1); PG8_BAR;
            PG8_LDA(At, 0, 1); PG8_STAGE(PG8_SA(0, 0), a2, voffA);
            PG8_BAR; PG8_WAIT_L(0); PG8_MMA(1, 0, At, B0); PG8_BAR; PG8_SCHED;
            PG8_STAGE(PG8_SB(0, 1), b2 + hstepB, voffB);
            PG8_WAIT_V(6); PG8_BAR; PG8_MMA(1, 1, At, B1); PG8_BAR;
            PG8_LDB(B0, 1, 0); PG8_SCHED; PG8_LDA(At, 1, 0); PG8_STAGE(PG8_SA(0, 1), a2 + hstepA, voffA);
            PG8_WAIT_L(8); PG8_BAR; PG8_WAIT_L(0); PG8_MMA(0, 0, At, B0); PG8_BAR; PG8_SCHED;
            PG8_LDB(B1, 1, 1); PG8_STAGE(PG8_SB(1, 0), b3, voffB);
            PG8_BAR; PG8_WAIT_L(0); PG8_MMA(0, 1, At, B1); PG8_BAR;
            PG8_LDA(At, 1, 1); PG8_STAGE(PG8_SA(1, 0), a3, voffA);
            PG8_BAR; PG8_WAIT_L(0); PG8_MMA(1, 0, At, B0); PG8_BAR; PG8_SCHED;
            PG8_STAGE(PG8_SB(1, 1), b3 + hstepB, voffB);
            PG8_WAIT_V(6); PG8_BAR; PG8_MMA(1, 1, At, B1); PG8_BAR;
        }
        E(acc, cur, wr, wc, fr, fq);
        if (!has_next) break;
#pragma unroll
        for (int a = 0; a < 2; ++a)
#pragma unroll
            for (int b = 0; b < 2; ++b)
#pragma unroll
                for (int m = 0; m < 4; ++m)
#pragma unroll
                    for (int n = 0; n < 2; ++n) acc[a][b][m][n] = (f32x4){0.f, 0.f, 0.f, 0.f};
        cur = nxt; cA = nA; cB = nB; ++ui;
    }
    PG8_WAIT_V(0);
    if (wr == 0) PG8_BAR;
    PG8_BAR;
#undef PG8_SA
#undef PG8_SB
#undef PG8_STAGE
#undef PG8_LDA
#undef PG8_LDB
#undef PG8_MMA
#undef PG8_WAIT_V
#undef PG8_WAIT_L
#undef PG8_BAR
#undef PG8_SCHED
}

__device__ __forceinline__ void rows_rstd(const float* ssq, int row0, int fq, float (&rsv)[8]) {
    f32x4 q[8];
#pragma unroll
    for (int r = 0; r < 8; ++r) q[r] = *(const f32x4*)(ssq + (size_t)(row0 + (r >> 2) * 128 + (r & 3) * 16) * 16 + 4 * fq);
#pragma unroll
    for (int r = 0; r < 8; ++r) { float a = (q[r][0] + q[r][1]) + (q[r][2] + q[r][3]); a += swz_xor<16>(a); a = sum_xor32(a); rsv[r] = rsqrtf(a * (1.0f / 1024.0f) + EPS); }
}
struct EpiGateUp {
    static constexpr bool PERM = false;
    bf16_t* O; const float* ssq; const float* tb;
    __device__ __forceinline__ void operator()(const f32x4 (&acc)[2][2][4][2], const Unit& u, int wr, int wc, int fr, int fq) const {
        const int row0 = u.pm * BM + wr * 64 + fr, col = u.pn * 128 + wc * 32 + fq * 8;
        const int b = tok_batch(u.pm * 256);
        const float* tbp = tb + (size_t)b * 5632 + u.pn * BM + wc * 32 + 4 * fq;
        const f32x4 tg0 = *(const f32x4*)(tbp), tu0 = *(const f32x4*)(tbp + 16), tg1 = *(const f32x4*)(tbp + HALF), tu1 = *(const f32x4*)(tbp + HALF + 16);
        float rsv[8]; rows_rstd(ssq, row0, fq, rsv);
#pragma unroll
        for (int ai = 0; ai < 2; ++ai)
#pragma unroll
            for (int m = 0; m < 4; ++m) {
                const int row = row0 + ai * HALF + m * 16;
                const float rs = rsv[ai * 4 + m];
                bf16_t* dst = O + (size_t)row * DFF + col;
                const f32x4 g0 = acc[ai][0][m][0] * rs + tg0, u0 = acc[ai][0][m][1] * rs + tu0, g1 = acc[ai][1][m][0] * rs + tg1, u1 = acc[ai][1][m][1] * rs + tu1;
                u32x4 w;
                w.x = cvt_pk_bf16(silu_f(g0[0]) * u0[0], silu_f(g0[1]) * u0[1]); w.y = cvt_pk_bf16(silu_f(g0[2]) * u0[2], silu_f(g0[3]) * u0[3]);
                w.z = cvt_pk_bf16(silu_f(g1[0]) * u1[0], silu_f(g1[1]) * u1[1]); w.w = cvt_pk_bf16(silu_f(g1[2]) * u1[2], silu_f(g1[3]) * u1[3]);
                *(u32x4*)dst = w;
            }
    }
};
__device__ __forceinline__ f32x4 safe_rcp4(f32x4 v) { f32x4 r; for (int e = 0; e < 4; ++e) r[e] = v[e] != 0.f ? 1.0f / v[e] : 0.f; return r; }
struct EpiResid {
    static constexpr bool PERM = false;
    const float* gate; float coef; int tile0;
    bf16_t* XS; const float* gprev; const float* scprev; const float* gnext; const float* scnext; float* ssq;
    __device__ __forceinline__ void operator()(f32x4 (&acc)[2][2][4][2], const Unit& u, int wr, int wc, int fr, int fq) const {
        int upm = u.pm, upn = u.pn; float cf = coef;
        typedef __attribute__((address_space(1))) float gf32; typedef __attribute__((address_space(1))) bf16_t gbf16;
        typedef __attribute__((address_space(1))) f32x4 gf32x4; typedef __attribute__((address_space(1))) u32x2 gu32x2;
        gbf16* XSp = (gbf16*)XS; gf32* sqp = (gf32*)ssq; const gf32* gtp = (const gf32*)gate; const gf32* gnp = (const gf32*)gnext; const gf32* scp = (const gf32*)scnext;
        const gf32* gpp = (const gf32*)gprev; const gf32* spp = (const gf32*)scprev;
        asm volatile("" : "+s"(upm), "+s"(upn), "+v"(cf), "+s"(XSp), "+s"(sqp), "+s"(gtp), "+s"(gnp), "+s"(scp), "+s"(gpp), "+s"(spp));
        const int row0 = upm * BM + wr * 64 + fr, col0 = upn * BM + wc * 32 + 4 * fq;
        const int b = tok_batch((tile0 + upm) * 256);
        f32x4 t0[2][2], t1[2][2], t2[2][2], inv[2][2], cs[2][2]; u32x2 xr[3][2][2];
#pragma unroll
        for (int bj = 0; bj < 2; ++bj)
#pragma unroll
            for (int n = 0; n < 2; ++n) { t0[bj][n] = *(const gf32x4*)(gtp + (size_t)b * MODW + col0 + bj * HALF + n * 16);
                t1[bj][n] = *(const gf32x4*)(gpp + col0 + bj * HALF + n * 16);
                t2[bj][n] = *(const gf32x4*)(spp + (size_t)b * MODW + col0 + bj * HALF + n * 16); }
#pragma unroll
        for (int q = 0; q < 2; ++q)
#pragma unroll
            for (int bj = 0; bj < 2; ++bj)
#pragma unroll
                for (int n = 0; n < 2; ++n) xr[q][bj][n] = *(const gu32x2*)(XSp + (size_t)(row0 + q * 16) * DM + col0 + bj * HALF + n * 16);
        __builtin_amdgcn_sched_barrier(0);
#pragma unroll
        for (int bj = 0; bj < 2; ++bj)
#pragma unroll
            for (int n = 0; n < 2; ++n) { const f32x4 g = t0[bj][n] * cf; inv[bj][n] = safe_rcp4(t1[bj][n] * (t2[bj][n] + 1.0f));
#pragma unroll
                for (int ai = 0; ai < 2; ++ai)
#pragma unroll
                    for (int m = 0; m < 4; ++m) acc[ai][bj][m][n] = acc[ai][bj][m][n] * g; }
        __builtin_amdgcn_sched_barrier(0);
#pragma unroll
        for (int bj = 0; bj < 2; ++bj)
#pragma unroll
            for (int n = 0; n < 2; ++n) { t0[bj][n] = *(const gf32x4*)(gnp + col0 + bj * HALF + n * 16); t1[bj][n] = *(const gf32x4*)(scp + (size_t)b * MODW + col0 + bj * HALF + n * 16); }
        __builtin_amdgcn_sched_barrier(0);
#pragma unroll
        for (int bj = 0; bj < 2; ++bj)
#pragma unroll
            for (int n = 0; n < 2; ++n) cs[bj][n] = t0[bj][n] * (t1[bj][n] + 1.0f);
#pragma unroll
        for (int r = 0; r < 8; ++r) {
            const int ai = r >> 2, m = r & 3;
            const int row = row0 + ai * HALF + m * 16; float ss = 0.f;
            if (r + 2 < 8) { const int rown = row0 + ((r + 2) >> 2) * HALF + ((r + 2) & 3) * 16;
#pragma unroll
                for (int bj = 0; bj < 2; ++bj)
#pragma unroll
                    for (int n = 0; n < 2; ++n) xr[(r + 2) % 3][bj][n] = *(const gu32x2*)(XSp + (size_t)rown * DM + col0 + bj * HALF + n * 16); }
#pragma unroll
            for (int bj = 0; bj < 2; ++bj)
#pragma unroll
                for (int n = 0; n < 2; ++n) { const u32x2 xo = xr[r % 3][bj][n];
                    const f32x4 xn = (f32x4){lo_bf(xo.x), hi_bf(xo.x), lo_bf(xo.y), hi_bf(xo.y)} * inv[bj][n] + acc[ai][bj][m][n];
                    ss += (xn[0] * xn[0] + xn[1] * xn[1]) + (xn[2] * xn[2] + xn[3] * xn[3]); const f32x4 y = xn * cs[bj][n];
                    u32x2 w; w.x = cvt_pk_bf16(y[0], y[1]); w.y = cvt_pk_bf16(y[2], y[3]); *(gu32x2*)(XSp + (size_t)row * DM + col0 + bj * HALF + n * 16) = w; }
            ss += swz_xor<16>(ss); ss = sum_xor32(ss); sqp[(size_t)row * 16 + upn * 4 + wc] = ss;
            __builtin_amdgcn_sched_barrier(0);
        }
    }
};
struct EpiResidLast {
    static constexpr bool PERM = false;
    const bf16_t* XS; const float* gprev; const float* scprev; const float* gate; float coef; float* lo; float* hi_;
    __device__ __forceinline__ void operator()(f32x4 (&acc)[2][2][4][2], const Unit& u, int wr, int wc, int fr, int fq) const {
        const int row0 = u.pm * BM + wr * 64 + fr, col0 = u.pn * BM + wc * 32 + 4 * fq;
        const int b = tok_batch(u.pm * 256);
        float* dst = (u.pm * BM < T_ALL / 2) ? lo : hi_;
        f32x4 gv[2][2], inv[2][2];
#pragma unroll
        for (int bj = 0; bj < 2; ++bj)
#pragma unroll
            for (int n = 0; n < 2; ++n) { gv[bj][n] = *(const f32x4*)(gate + (size_t)b * MODW + col0 + bj * HALF + n * 16) * coef;
                inv[bj][n] = safe_rcp4(*(const f32x4*)(gprev + col0 + bj * HALF + n * 16) * (*(const f32x4*)(scprev + (size_t)b * MODW + col0 + bj * HALF + n * 16) + 1.0f)); }
#pragma unroll
        for (int ai = 0; ai < 2; ++ai)
#pragma unroll
            for (int m = 0; m < 4; ++m) { const int row = row0 + ai * HALF + m * 16;
                u32x2 xo[2][2];
#pragma unroll
                for (int bj = 0; bj < 2; ++bj)
#pragma unroll
                    for (int n = 0; n < 2; ++n) xo[bj][n] = *(const u32x2*)(XS + (size_t)row * DM + col0 + bj * HALF + n * 16);
#pragma unroll
                for (int bj = 0; bj < 2; ++bj)
#pragma unroll
                    for (int n = 0; n < 2; ++n) { const u32x2 q = xo[bj][n];
                        *(f32x4*)(dst + (size_t)row * DM + col0 + bj * HALF + n * 16) = (f32x4){lo_bf(q.x), hi_bf(q.x), lo_bf(q.y), hi_bf(q.y)} * inv[bj][n] + gv[bj][n] * acc[ai][bj][m][n]; } }
    }
};
struct EpiBf16 {
    static constexpr bool PERM = true;
    bf16_t* O; int ldc;
    __device__ __forceinline__ void operator()(const f32x4 (&acc)[2][2][4][2], const Unit& u, int wr, int wc, int fr, int fq) const {
        const int row0 = u.pm * BM + wr * 64 + fr, col0 = u.pn * BM + wc * 32 + 8 * fq;
#pragma unroll
        for (int ai = 0; ai < 2; ++ai)
#pragma unroll
            for (int m = 0; m < 4; ++m) { bf16_t* rowp = O + (size_t)(row0 + ai * HALF + m * 16) * ldc + col0;
#pragma unroll
                for (int bj = 0; bj < 2; ++bj) { const f32x4 v0 = acc[ai][bj][m][0], v1 = acc[ai][bj][m][1];
                    u32x4 w; w.x = cvt_pk_bf16(v0[0], v0[1]); w.y = cvt_pk_bf16(v0[2], v0[3]); w.z = cvt_pk_bf16(v1[0], v1[1]); w.w = cvt_pk_bf16(v1[2], v1[3]);
                    *(u32x4*)(rowp + bj * HALF) = w; } }
    }
};
struct EpiBf16N {
    static constexpr bool PERM = true;
    bf16_t* O; int ldc; const float* ssq; const float* tb; int ldtb; int tile0;
    __device__ __forceinline__ void operator()(const f32x4 (&acc)[2][2][4][2], const Unit& u, int wr, int wc, int fr, int fq) const {
        const int row0 = u.pm * BM + wr * 64 + fr, col0 = u.pn * BM + wc * 32 + 8 * fq;
        const int b = tok_batch((tile0 + u.pm) * 256);
        const float* tbp = tb + (size_t)b * ldtb + col0;
        const f32x4 t00 = *(const f32x4*)(tbp), t01 = *(const f32x4*)(tbp + 4), t10 = *(const f32x4*)(tbp + HALF), t11 = *(const f32x4*)(tbp + HALF + 4);
        float rsv[8]; rows_rstd(ssq, row0, fq, rsv);
#pragma unroll
        for (int ai = 0; ai < 2; ++ai)
#pragma unroll
            for (int m = 0; m < 4; ++m) { const int row = row0 + ai * HALF + m * 16; bf16_t* rowp = O + (size_t)row * ldc + col0;
                const float rs = rsv[ai * 4 + m];
#pragma unroll
                for (int bj = 0; bj < 2; ++bj) { const f32x4 v0 = acc[ai][bj][m][0] * rs + (bj ? t10 : t00), v1 = acc[ai][bj][m][1] * rs + (bj ? t11 : t01);
                    u32x4 w; w.x = cvt_pk_bf16(v0[0], v0[1]); w.y = cvt_pk_bf16(v0[2], v0[3]); w.z = cvt_pk_bf16(v1[0], v1[1]); w.w = cvt_pk_bf16(v1[2], v1[3]);
                    *(u32x4*)(rowp + bj * HALF) = w; } }
    }
};
struct EpiKV {
    static constexpr bool PERM = true;
    bf16_t* Kn; bf16_t* V;
    __device__ __forceinline__ void operator()(const f32x4 (&acc)[2][2][4][2], const Unit& u, int wr, int wc, int fr, int fq) const {
        const int row0 = u.pm * BM + wr * 64 + fr, col0 = u.pn * 128 + wc * 32 + 8 * fq;
#pragma unroll
        for (int ai = 0; ai < 2; ++ai)
#pragma unroll
            for (int m = 0; m < 4; ++m) { const size_t off = (size_t)(row0 + ai * HALF + m * 16) * 1024 + col0;
#pragma unroll
                for (int bj = 0; bj < 2; ++bj) { const f32x4 v0 = acc[ai][bj][m][0], v1 = acc[ai][bj][m][1];
                    u32x4 w; w.x = cvt_pk_bf16(v0[0], v0[1]); w.y = cvt_pk_bf16(v0[2], v0[3]); w.z = cvt_pk_bf16(v1[0], v1[1]); w.w = cvt_pk_bf16(v1[2], v1[3]);
                    *(u32x4*)((bj ? V : Kn) + off) = w; } }
    }
};
}

template <class Epi>
__device__ __forceinline__ void run_gemm(LAS unsigned char* lds, const bf16_t* A, int lda, const bf16_t* Bt, int ldb, int M, int N, int K, const Epi& E) {
    pg8::Gemm g; g.A = A; g.Bt = Bt; g.M = M; g.N = N; g.K = K; g.lda = lda; g.ldb = ldb;
    pg8::StaticOrder S; S.init(M, N, (int)gridDim.x, opaque_bid());
    pg8::gemm_phase<Epi>(lds, g, S, E);
}

__device__ __forceinline__ void prep_mod(const Params& p, unsigned char* shm) {
    float* cact = (float*)shm;
    float* red = (float*)(shm + 81920);
    const int tid = opaque_tid(), bid = opaque_bid();
    if (bid >= 304) return;
    for (int idx = tid; idx < NSEQ * 1024; idx += 512) {
        const int b = idx >> 10, k = idx & 1023;
        const float c = b < 16 ? p.in[2][b * 1024 + k] : p.in[3][(b - 16) * 1024 + k];
        cact[k * NSEQ + b] = c / (1.0f + expf(-c));
    }
    __syncthreads();
    float* modbase = (float*)(p.ws + OFF_MOD);
    for (int it = bid; it < 304; it += gridDim.x) {
        const int mat = it < 288 ? it / 72 : 4, chunk = it < 288 ? it % 72 : it - 288, n0 = chunk * 128;
        const float* W = mat < 4 ? p.in[4] + (size_t)mat * 1024 * MODW : p.in[21];
        const float* bias = mat < 4 ? p.in[5] + mat * MODW : p.in[22];
        const int ldw = mat < 4 ? MODW : 2048;
        float* outp = mat < 4 ? modbase + (size_t)mat * NSEQ * MODW : modbase + 4ull * NSEQ * MODW;
        const int nl = tid & 127, ks = tid >> 7;
        float acc[NSEQ];
#pragma unroll
        for (int b = 0; b < NSEQ; ++b) acc[b] = 0.f;
        const float* wp = W + (size_t)(ks * 256) * ldw + n0 + nl;
#pragma unroll 4
        for (int k = 0; k < 256; ++k) {
            const float w = wp[(size_t)k * ldw];
            const f32x4* cv = (const f32x4*)(cact + (ks * 256 + k) * NSEQ);
#pragma unroll
            for (int q = 0; q < 5; ++q) { const f32x4 c4 = cv[q]; acc[q * 4 + 0] += c4[0] * w; acc[q * 4 + 1] += c4[1] * w; acc[q * 4 + 2] += c4[2] * w; acc[q * 4 + 3] += c4[3] * w; }
        }
#pragma unroll
        for (int b = 0; b < NSEQ; ++b) red[(ks * 128 + nl) * NSEQ + b] = acc[b];
        __syncthreads();
        for (int o = tid; o < 128 * NSEQ; o += 512) {
            const int b = o >> 7, n = o & 127;
            const float s = red[(0 * 128 + n) * NSEQ + b] + red[(1 * 128 + n) * NSEQ + b] + red[(2 * 128 + n) * NSEQ + b] + red[(3 * 128 + n) * NSEQ + b];
            outp[(size_t)b * ldw + n0 + n] = s + bias[n0 + n];
        }
        __syncthreads();
    }
}

__device__ __forceinline__ void prep_rope(const Params& p) {
    f32x2* tab = (f32x2*)(p.ws + OFF_ROPE);
    for (int i = opaque_bid() * 512 + opaque_tid(); i < 8192 * 32; i += gridDim.x * 512) {
        const int pos = i >> 5, j = i & 31;
        const float inv = 1.0f / powf(10000.0f, (float)(2 * j) / 64.0f);
        const float ang = (float)pos * inv;
        float s, c; sincosf(ang, &s, &c);
        tab[i] = (f32x2){c, s};
    }
}

__device__ __forceinline__ void prep_weights(const Params& p, unsigned char* shm) {
    float* tile = (float*)shm;
    const int tid = opaque_tid();
    bf16_t* Wb = (bf16_t*)(p.ws + OFF_W);
    constexpr int T_GU = 88 * 8, T_DN = 16 * 22, T_FFN = T_GU + T_DN, T_FFN_ALL = 8 * T_FFN;
    constexpr int T_GIN = 52 * 8, T_GOUT = 128, T_MIN = 8 * 8, T_UQ = 24 * 2, T_UKV = 32 * 2, T_MOUT = 128, T_MIX = T_GIN + T_GOUT + T_MIN + T_UQ + T_UKV + T_MOUT;
    constexpr int T_TOTAL = T_FFN_ALL + 2 * T_MIX;
    for (int idx = opaque_bid(); idx < T_TOTAL; idx += gridDim.x) {
        const float* src; const float* src2 = nullptr; int ldsrc, ksrc, nsrc, ldk, NT, mode = 0, loc; bf16_t* dst;
        if (idx < T_FFN_ALL) {
            const int lw = idx / T_FFN; loc = idx % T_FFN;
            if (loc < T_GU) { src = p.in[7] + (size_t)lw * 1024 * DFF; src2 = p.in[8] + (size_t)lw * 1024 * DFF; ldsrc = DFF; ksrc = 1024; nsrc = DFF; ldk = 1024; NT = 88; mode = 1; dst = Wb + (size_t)lw * W_FFN_STRIDE; }
            else { loc -= T_GU; src = p.in[9] + (size_t)lw * DFF * 1024; ldsrc = 1024; ksrc = DFF; nsrc = 1024; ldk = DFF; NT = 16; dst = Wb + (size_t)lw * W_FFN_STRIDE + SZ_GU; }
        } else {
            const int r = idx - T_FFN_ALL, j = r / T_MIX; loc = r % T_MIX;
            bf16_t* mb = Wb + W_FFN_TOTAL + (size_t)j * W_MIX_STRIDE;
            if (loc < T_GIN) { src = p.in[10] + (size_t)j * 1024 * 3104; ldsrc = 3104; ksrc = 1024; nsrc = 3104; ldk = 1024; NT = 52; dst = mb; }
            else if ((loc -= T_GIN) < T_GOUT) { src = p.in[14] + (size_t)j * 1024 * 1024; ldsrc = 1024; ksrc = 1024; nsrc = 1024; ldk = 1024; NT = 16; dst = mb + SZ_GIN; }
            else if ((loc -= T_GOUT) < T_MIN) { src = p.in[15] + (size_t)j * 1024 * 448; ldsrc = 448; ksrc = 1024; nsrc = 448; ldk = 1024; NT = 8; dst = mb + SZ_GIN + SZ_GOUT; }
            else if ((loc -= T_MIN) < T_UQ) { src = p.in[18] + (size_t)j * 256 * 1536; ldsrc = 1536; ksrc = 256; nsrc = 1536; ldk = 256; NT = 24; dst = mb + SZ_GIN + SZ_GOUT + SZ_MIN; }
            else if ((loc -= T_UQ) < T_UKV) { src = p.in[19] + (size_t)j * 128 * 2048; ldsrc = 2048; ksrc = 128; nsrc = 2048; ldk = 256; NT = 32; dst = mb + SZ_GIN + SZ_GOUT + SZ_MIN + SZ_UQ; }
            else { loc -= T_UKV; src = p.in[20] + (size_t)j * 1024 * 1024; ldsrc = 1024; ksrc = 1024; nsrc = 1024; ldk = 1024; NT = 16; dst = mb + SZ_GIN + SZ_GOUT + SZ_MIN + SZ_UQ + SZ_UKV; }
        }
        const int n0 = (loc % NT) * 64, k0 = (loc / NT) * 128;
        {
            const int j = tid & 63, kk = tid >> 6;
            int col = n0 + j; const float* sp = src;
            if (mode == 1) { const int nsel = n0 >= DFF ? 1 : 0; col = n0 - nsel * DFF + j; sp = nsel ? src2 : src; }
#pragma unroll
            for (int i = 0; i < 16; ++i) { const int k = k0 + kk + 8 * i;
                tile[(kk + 8 * i) * 65 + j] = (k < ksrc && col < nsrc) ? sp[(size_t)k * ldsrc + col] : 0.f; }
        }
        __syncthreads();
        {
            const int j = tid >> 3, kc = (tid & 7) * 8;
            int drow = n0 + j;
            if (mode == 1) { const int nsel = n0 >= DFF ? 1 : 0, c = n0 - nsel * DFF + j;
                drow = 256 * (c >> 7) + 128 * ((c >> 2) & 1) + 32 * ((c >> 5) & 3) + 16 * nsel + 4 * ((c >> 3) & 3) + (c & 3); }
#pragma unroll
            for (int h = 0; h < 2; ++h) {
                float v[8];
#pragma unroll
                for (int e = 0; e < 8; ++e) v[e] = tile[(h * 64 + kc + e) * 65 + j];
                u32x4 w; w.x = cvt_pk_bf16(v[0], v[1]); w.y = cvt_pk_bf16(v[2], v[3]); w.z = cvt_pk_bf16(v[4], v[5]); w.w = cvt_pk_bf16(v[6], v[7]);
                *(u32x4*)(dst + (size_t)drow * ldk + k0 + h * 64 + kc) = w;
            }
        }
        __syncthreads();
    }
}

__device__ __forceinline__ void phase_tb(const Params& p, unsigned char* shm) {
    float* sh = (float*)shm;
    const int tid = opaque_tid(), wid = tid >> 6, lane = tid & 63;
    const bf16_t* Wb = (const bf16_t*)(p.ws + OFF_W);
    const float* modb = (const float*)(p.ws + OFF_MOD);
    float* tball = (float*)(p.ws + OFF_TB);
    constexpr int U_FFN = 88, U_PROJ = 52, U_CIN = 8, U_TOTAL = 8 * U_FFN + 2 * U_PROJ + 2 * U_CIN;
    int loaded = -1;
    for (int un = opaque_bid(); un < U_TOTAL; un += gridDim.x) {
        int tab, chunk, N; const bf16_t* W; const float* shift; float* out;
        if (un < 8 * U_FFN) { tab = un / U_FFN; chunk = un % U_FFN; N = 5632; const int l = tab >> 1, w = tab & 1;
            W = Wb + (size_t)tab * W_FFN_STRIDE; shift = modb + (size_t)l * NSEQ * MODW + (w ? 6 : 0) * 1024; out = tball + (size_t)tab * TB_FFN_SZ; }
        else if (un < 8 * U_FFN + 2 * U_PROJ) { const int r = un - 8 * U_FFN, j = r / U_PROJ; chunk = r % U_PROJ; tab = 8 + j; N = 3328;
            W = Wb + W_FFN_TOTAL + (size_t)j * W_MIX_STRIDE; shift = modb + (size_t)(2 * j) * NSEQ * MODW + 3 * 1024; out = tball + 8 * TB_FFN_SZ + (size_t)j * TB_PROJ_SZ; }
        else { const int r = un - 8 * U_FFN - 2 * U_PROJ, j = r / U_CIN; chunk = r % U_CIN; tab = 10 + j; N = 512;
            W = Wb + W_FFN_TOTAL + (size_t)j * W_MIX_STRIDE + SZ_GIN + SZ_GOUT; shift = modb + (size_t)(2 * j + 1) * NSEQ * MODW + 3 * 1024; out = tball + 8 * TB_FFN_SZ + 2 * TB_PROJ_SZ + (size_t)j * TB_CIN_SZ; }
        if (tab != loaded) {
            __syncthreads();
            for (int i = tid; i < NSEQ * 1024; i += 512) sh[i] = shift[(size_t)(i >> 10) * MODW + (i & 1023)];
            __syncthreads();
            loaded = tab;
        }
#pragma unroll 1
        for (int rr = 0; rr < 8; ++rr) {
            const int n = chunk * 64 + wid * 8 + rr;
            const u32x4 w0 = *(const u32x4*)(W + (size_t)n * 1024 + lane * 16), w1 = *(const u32x4*)(W + (size_t)n * 1024 + lane * 16 + 8);
            float wv[16];
#pragma unroll
            for (int q = 0; q < 4; ++q) { wv[2 * q] = lo_bf(w0[q]); wv[2 * q + 1] = hi_bf(w0[q]); wv[8 + 2 * q] = lo_bf(w1[q]); wv[8 + 2 * q + 1] = hi_bf(w1[q]); }
            float mine = 0.f;
#pragma unroll 2
            for (int bb = 0; bb < NSEQ; ++bb) {
                const f32x4* sp = (const f32x4*)(sh + bb * 1024 + lane * 16);
                float a = 0.f;
#pragma unroll
                for (int q = 0; q < 4; ++q) { const f32x4 s4 = sp[q]; a += s4[0] * wv[4 * q] + s4[1] * wv[4 * q + 1] + s4[2] * wv[4 * q + 2] + s4[3] * wv[4 * q + 3]; }
                a = wave_sum(a);
                mine = (lane == bb) ? a : mine;
            }
            if (lane < NSEQ) out[(size_t)lane * N + n] = mine;
        }
    }
}

__device__ __forceinline__ void phase_prenorm(const Params& p) {
    const int tid = opaque_tid(), wid = tid >> 6, lane = tid & 63;
    const float* g = p.in[6]; const float* scale = (const float*)(p.ws + OFF_MOD) + 1024;
    bf16_t* XS = (bf16_t*)p.out; float* ssq = (float*)(p.ws + OFF_SSQ);
    for (int row = opaque_bid() * 8 + wid; row < T_ALL; row += gridDim.x * 8) {
        const int b = tok_batch(row);
        const float* xr = row < 65536 ? p.in[0] + (size_t)row * DM : p.in[1] + (size_t)(row - 65536) * DM;
        f32x4 v[4]; float ss = 0.f;
#pragma unroll
        for (int j = 0; j < 4; ++j) { v[j] = *(const f32x4*)(xr + j * 256 + lane * 4); ss += v[j][0] * v[j][0] + v[j][1] * v[j][1] + v[j][2] * v[j][2] + v[j][3] * v[j][3]; }
        ss = wave_sum(ss);
        if (lane < 16) ssq[(size_t)row * 16 + lane] = lane == 0 ? ss : 0.f;
#pragma unroll
        for (int j = 0; j < 4; ++j) {
            const int c = j * 256 + lane * 4;
            const f32x4 gg = *(const f32x4*)(g + c), sc = *(const f32x4*)(scale + (size_t)b * MODW + c);
            const f32x4 y = v[j] * gg * (sc + 1.0f);
            u32x2 w; w.x = cvt_pk_bf16(y[0], y[1]); w.y = cvt_pk_bf16(y[2], y[3]); *(u32x2*)(XS + (size_t)row * DM + c) = w;
        }
    }
}

__device__ __forceinline__ void phase_final(const float* xlo, float* out, const float* g, const float* shift, const float* scale, int ldmod) {
    const int tid = opaque_tid(), wid = tid >> 6, lane = tid & 63;
    for (int row = opaque_bid() * 8 + wid; row < T_ALL; row += gridDim.x * 8) {
        const int b = tok_batch(row);
        const float* xr = (row < T_ALL / 2 ? xlo : (const float*)out) + (size_t)row * DM;
        f32x4 v[4]; float ss = 0.f;
#pragma unroll
        for (int j = 0; j < 4; ++j) { v[j] = *(const f32x4*)(xr + j * 256 + lane * 4); ss += v[j][0] * v[j][0] + v[j][1] * v[j][1] + v[j][2] * v[j][2] + v[j][3] * v[j][3]; }
        ss = wave_sum(ss);
        const float rstd = rsqrtf(ss * (1.0f / 1024.0f) + EPS);
#pragma unroll
        for (int j = 0; j < 4; ++j) {
            const int c = j * 256 + lane * 4;
            const f32x4 gg = *(const f32x4*)(g + c), sh = *(const f32x4*)(shift + (size_t)b * ldmod + c), sc = *(const f32x4*)(scale + (size_t)b * ldmod + c);
            f32x4 y;
#pragma unroll
            for (int e = 0; e < 4; ++e) y[e] = (v[j][e] * rstd * gg[e]) * (1.0f + sc[e]) + sh[e];
            *(f32x4*)(out + (size_t)row * DM + c) = y;
        }
    }
}

__device__ __forceinline__ void phase_gla_combine(const Params& p, int j, int grp) {
    const bf16_t* proj = (const bf16_t*)(p.ws + OFF_ACT + GLA_PROJ);
    const bf16_t* of = (const bf16_t*)(p.ws + OFF_ACT + GLA_OF);
    const bf16_t* ob = (const bf16_t*)(p.ws + OFF_ACT + GLA_OB);
    bf16_t* gated = (bf16_t*)(p.ws + OFF_ACT + GLA_OF);
    const float* gn = p.in[13] + j * 256;
    const int tid = opaque_tid(), wid = tid >> 6, lane = tid & 63;
    float gnv[16];
#pragma unroll
    for (int e = 0; e < 16; ++e) gnv[e] = gn[((lane & 15) * 16 + e)];
    for (int tok = opaque_bid() * 8 + wid; tok < TG; tok += gridDim.x * 8) {
        const u32x4 f0 = *(const u32x4*)(of + (size_t)tok * 1024 + lane * 16), f1 = *(const u32x4*)(of + (size_t)tok * 1024 + lane * 16 + 8);
        const u32x4 b0 = *(const u32x4*)(ob + (size_t)tok * 1024 + lane * 16), b1 = *(const u32x4*)(ob + (size_t)tok * 1024 + lane * 16 + 8);
        const u32x4 r0 = *(const u32x4*)(proj + (size_t)tok * 3328 + 2048 + lane * 16), r1 = *(const u32x4*)(proj + (size_t)tok * 3328 + 2048 + lane * 16 + 8);
        float o[16], r[16];
#pragma unroll
        for (int q = 0; q < 4; ++q) {
            o[2 * q] = lo_bf(f0[q]) + lo_bf(b0[q]); o[2 * q + 1] = hi_bf(f0[q]) + hi_bf(b0[q]);
            o[8 + 2 * q] = lo_bf(f1[q]) + lo_bf(b1[q]); o[8 + 2 * q + 1] = hi_bf(f1[q]) + hi_bf(b1[q]);
            r[2 * q] = lo_bf(r0[q]); r[2 * q + 1] = hi_bf(r0[q]); r[8 + 2 * q] = lo_bf(r1[q]); r[8 + 2 * q + 1] = hi_bf(r1[q]);
        }
        float ss = 0.f;
#pragma unroll
        for (int e = 0; e < 16; ++e) ss += o[e] * o[e];
        ss += swz_xor<1>(ss); ss += swz_xor<2>(ss); ss += swz_xor<4>(ss); ss += swz_xor<8>(ss);
        const float rstd = rsqrtf(ss * (1.0f / 256.0f) + EPS);
        float y[16];
#pragma unroll
        for (int e = 0; e < 16; ++e) y[e] = silu_f(r[e]) * (o[e] * rstd * gnv[e]);
        u32x4 w0, w1;
        w0.x = cvt_pk_bf16(y[0], y[1]); w0.y = cvt_pk_bf16(y[2], y[3]); w0.z = cvt_pk_bf16(y[4], y[5]); w0.w = cvt_pk_bf16(y[6], y[7]);
        w1.x = cvt_pk_bf16(y[8], y[9]); w1.y = cvt_pk_bf16(y[10], y[11]); w1.z = cvt_pk_bf16(y[12], y[13]); w1.w = cvt_pk_bf16(y[14], y[15]);
        *(u32x4*)(gated + (size_t)tok * 1024 + lane * 16) = w0; *(u32x4*)(gated + (size_t)tok * 1024 + lane * 16 + 8) = w1;
    }
}

__device__ __forceinline__ void phase_mla_normrope(const Params& p, int j, int grp) {
    const bf16_t* cin = (const bf16_t*)(p.ws + OFF_ACT + MLA_CIN);
    bf16_t* cn = (bf16_t*)(p.ws + OFF_ACT + MLA_CN);
    bf16_t* kr = (bf16_t*)(p.ws + OFF_ACT + MLA_KR);
    const f32x2* rope = (const f32x2*)(p.ws + OFF_ROPE);
    const float* gq = p.in[16] + j * 256; const float* gkv = p.in[17] + j * 128;
    const int tid = opaque_tid(), wid = tid >> 6, lane = tid & 63;
    const f32x4 gqv = *(const f32x4*)(gq + lane * 4); const f32x2 gkvv = *(const f32x2*)(gkv + lane * 2);
    for (int tok = opaque_bid() * 8 + wid; tok < TG; tok += gridDim.x * 8) {
        const bf16_t* row = cin + (size_t)tok * 512;
        const u32x2 cq = *(const u32x2*)(row + lane * 4);
        const unsigned ck = *(const unsigned*)(row + 256 + lane * 2);
        const float x = bf2f(row[384 + lane]);
        const float q0 = lo_bf(cq.x), q1 = hi_bf(cq.x), q2 = lo_bf(cq.y), q3 = hi_bf(cq.y), k0 = lo_bf(ck), k1 = hi_bf(ck);
        float ssq = q0 * q0 + q1 * q1 + q2 * q2 + q3 * q3, ssk = k0 * k0 + k1 * k1;
        ssq = wave_sum(ssq); ssk = wave_sum(ssk);
        const float rq = rsqrtf(ssq * (1.0f / 256.0f) + EPS), rk = rsqrtf(ssk * (1.0f / 128.0f) + EPS);
        u32x2 wq; wq.x = cvt_pk_bf16(q0 * rq * gqv[0], q1 * rq * gqv[1]); wq.y = cvt_pk_bf16(q2 * rq * gqv[2], q3 * rq * gqv[3]);
        *(u32x2*)(cn + (size_t)tok * 512 + lane * 4) = wq;
        *(unsigned*)(cn + (size_t)tok * 512 + 256 + lane * 2) = cvt_pk_bf16(k0 * rk * gkvv[0], k1 * rk * gkvv[1]);
        *(unsigned*)(cn + (size_t)tok * 512 + 384 + lane * 2) = 0u;
        const float other = get_xor32(x, lane >> 5);
        const int pos = tok_pos(grp * TG + tok);
        const f32x2 cs = rope[pos * 32 + (lane & 31)];
        const float y = lane < 32 ? (x * cs[0] - other * cs[1]) : (other * cs[1] + x * cs[0]);
        kr[(size_t)tok * 64 + lane] = f2bf(y);
    }
}

namespace att {
constexpr int DQK = 192, DV = 128, NW = 8, QBLK = 32, KVBLK = 64;
constexpr float SCALE = 0.07216878364870322f;
constexpr float THR = 8.f;
constexpr int LDQ = 1536, LDK = 1024, LDKR = 64, LDO = 1024;
constexpr int SHM_V = KVBLK * DV * 2, SHM_K = KVBLK * DQK * 2, SHM_ATTN = 3 * SHM_V + 3 * SHM_K + NW * 64 * 4;
static_assert(SHM_ATTN <= LDS_MAIN, "attention LDS");
#define KSWZ(row, colB) ((row) * 384 + ((colB) ^ ((((row) >> 1) & 7) << 4)))
#define SBAR() __builtin_amdgcn_sched_barrier(0)
__device__ __forceinline__ int crow(int r, int hi) { return (r & 3) + 8 * (r >> 2) + 4 * hi; }
__device__ __forceinline__ void partialSM(f32x16& p0, f32x16& p1, float& m_reg, float& mn, float& alpha) {
    constexpr float C = SCALE * 1.4426950408889634f;
    float pmax = p0[0];
#pragma unroll
    for (int r = 1; r < 16; ++r) pmax = fmaxf(pmax, p0[r]);
#pragma unroll
    for (int r = 0; r < 16; ++r) pmax = fmaxf(pmax, p1[r]);
    { auto rr = __builtin_amdgcn_permlane32_swap(__float_as_uint(pmax), __float_as_uint(pmax), false, false);
      pmax = fmaxf(__uint_as_float(rr[0]), __uint_as_float(rr[1])); }
    if (__builtin_expect(__all(pmax - m_reg <= THR / SCALE), 1)) { mn = m_reg; alpha = 1.f; }
    else { mn = fmaxf(m_reg, pmax); alpha = __builtin_amdgcn_exp2f((m_reg - mn) * C); m_reg = mn; }
    const float mnC = -mn * C;
#pragma unroll
    for (int r = 0; r < 16; ++r) p0[r] = fmaf(p0[r], C, mnC);
#pragma unroll
    for (int r = 0; r < 16; ++r) p1[r] = fmaf(p1[r], C, mnC);
#pragma unroll
    for (int r = 0; r < 16; ++r) p0[r] = __builtin_amdgcn_exp2f(p0[r]);
}
__device__ __forceinline__ void finishSM(f32x16& p0, f32x16& p1, float alpha, float& l_reg, bf16x8& pa0, bf16x8& pa1, bf16x8& pa2, bf16x8& pa3) {
#pragma unroll
    for (int r = 0; r < 16; ++r) p1[r] = __builtin_amdgcn_exp2f(p1[r]);
    float ps = 0;
#pragma unroll
    for (int r = 0; r < 16; ++r) ps += p0[r];
#pragma unroll
    for (int r = 0; r < 16; ++r) ps += p1[r];
    { auto rr = __builtin_amdgcn_permlane32_swap(__float_as_uint(ps), __float_as_uint(ps), false, false);
      ps = __uint_as_float(rr[0]) + __uint_as_float(rr[1]); }
    l_reg = l_reg * alpha + ps;
#define PK4(P, BASE, OUT) do { unsigned a0 = cvt_pk_bf16(P[BASE + 0], P[BASE + 1]), a1 = cvt_pk_bf16(P[BASE + 2], P[BASE + 3]);   \
    unsigned b0 = cvt_pk_bf16(P[BASE + 4], P[BASE + 5]), b1 = cvt_pk_bf16(P[BASE + 6], P[BASE + 7]);                              \
    auto r0 = __builtin_amdgcn_permlane32_swap(a0, b0, false, false); auto r1 = __builtin_amdgcn_permlane32_swap(a1, b1, false, false); \
    u32x4 w = {r0[0], r1[0], r0[1], r1[1]}; OUT = *reinterpret_cast<bf16x8*>(&w); } while (0)
    PK4(p0, 0, pa0); PK4(p0, 8, pa1); PK4(p1, 0, pa2); PK4(p1, 8, pa3);
#undef PK4
}
__device__ __forceinline__ void qkt(f32x16& p0, f32x16& p1, const char* Ks, const bf16x8* qr, int r32, int hi) {
    p0 = f32x16{}; p1 = f32x16{};
#pragma unroll
    for (int d0 = 0; d0 < 12; ++d0) { const int cb = (d0 * 16 + hi * 8) * 2;
        const bf16x8 b0 = *reinterpret_cast<const bf16x8*>(Ks + KSWZ(r32, cb));
        const bf16x8 b1 = *reinterpret_cast<const bf16x8*>(Ks + KSWZ(32 + r32, cb));
        p0 = __builtin_amdgcn_mfma_f32_32x32x16_bf16(b0, qr[d0], p0, 0, 0, 0);
        p1 = __builtin_amdgcn_mfma_f32_32x32x16_bf16(b1, qr[d0], p1, 0, 0, 0); }
}
__device__ __forceinline__ int v_st(int k, int c) { const int kk = (k & ~0xC) | ((k & 4) << 1) | ((k & 8) >> 1); return ((kk >> 3) * 4 + (c >> 5)) * 512 + ((kk & 7) * 32 + (c & 31)) * 2; }
__device__ __forceinline__ int v_rd_base(int lane) { return ((lane & 3) << 3) | (((lane >> 2) & 3) << 6) | (((lane >> 4) & 1) << 5) | (((lane >> 5) & 1) << 8); }
constexpr int v_rd_off(int d0, int ks, int half) { return d0 * 512 + ks * 4096 + half * 2048; }
template <int OFF> __device__ __forceinline__ s16x4 tr_read(int vb) {
    s16x4 r; asm volatile("ds_read_b64_tr_b16 %0, %1 offset:%2" : "=&v"(r) : "v"(vb), "i"(OFF) : "memory"); return r;
}
template <int D0> __device__ __forceinline__ void pv_one(f32x16& od, int vb, bf16x8 pa0, bf16x8 pa1, bf16x8 pa2, bf16x8 pa3) {
    const s16x4 l0 = tr_read<v_rd_off(D0, 0, 0)>(vb), h0 = tr_read<v_rd_off(D0, 0, 1)>(vb), l1 = tr_read<v_rd_off(D0, 1, 0)>(vb), h1 = tr_read<v_rd_off(D0, 1, 1)>(vb);
    const s16x4 l2 = tr_read<v_rd_off(D0, 2, 0)>(vb), h2 = tr_read<v_rd_off(D0, 2, 1)>(vb), l3 = tr_read<v_rd_off(D0, 3, 0)>(vb), h3 = tr_read<v_rd_off(D0, 3, 1)>(vb);
    asm volatile("s_waitcnt lgkmcnt(0)" ::: "memory"); SBAR();
#define PK(L, H) (bf16x8){L[0], L[1], L[2], L[3], H[0], H[1], H[2], H[3]}
    od = __builtin_amdgcn_mfma_f32_32x32x16_bf16(PK(l0, h0), pa0, od, 0, 0, 0);
    od = __builtin_amdgcn_mfma_f32_32x32x16_bf16(PK(l1, h1), pa1, od, 0, 0, 0);
    od = __builtin_amdgcn_mfma_f32_32x32x16_bf16(PK(l2, h2), pa2, od, 0, 0, 0);
    od = __builtin_amdgcn_mfma_f32_32x32x16_bf16(PK(l3, h3), pa3, od, 0, 0, 0);
#undef PK
}
__device__ __forceinline__ void pv_d0(f32x16* o, int vb, bf16x8 pa0, bf16x8 pa1, bf16x8 pa2, bf16x8 pa3) {
    pv_one<0>(o[0], vb, pa0, pa1, pa2, pa3); pv_one<1>(o[1], vb, pa0, pa1, pa2, pa3); pv_one<2>(o[2], vb, pa0, pa1, pa2, pa3); pv_one<3>(o[3], vb, pa0, pa1, pa2, pa3);
}

__device__ __forceinline__ void body(const bf16_t* __restrict__ Qb, const bf16_t* __restrict__ Kn, const bf16_t* __restrict__ Kr, const bf16_t* __restrict__ Vh,
                                     bf16_t* __restrict__ Ob, int seq, int pos0, const f32x2* __restrict__ rope, char* lds, LAS unsigned char* ldsl) {
    const int tid = opaque_tid(), wid = tid >> 6, lane = tid & 63, r32 = lane & 31, hi = lane >> 5;
    char* V_lds = lds; char* K_lds = lds + 3 * SHM_V;
    float* ws = (float*)(lds + 3 * SHM_V + 3 * SHM_K) + wid * 64; float* li_l = ws; float* al_l = ws + 32;
    float m_reg = -1e30f, l_reg = 0; f32x16 o[4] = {}; bf16x8 qr[12];
    const bf16_t* Qw = Qb + (size_t)(wid * QBLK + r32) * LDQ + hi * 8;
#pragma unroll
    for (int d0 = 0; d0 < 12; ++d0) qr[d0] = *reinterpret_cast<const bf16x8*>(Qw + d0 * 16);
    {
        const f32x2* rp = rope + (size_t)(pos0 + wid * QBLK + r32) * 32;
#pragma unroll
        for (int dd = 0; dd < 2; ++dd) {
            bf16x8 x1 = qr[8 + dd], x2 = qr[10 + dd];
#pragma unroll
            for (int e = 0; e < 8; ++e) {
                const f32x2 cs = rp[dd * 16 + hi * 8 + e];
                const float a = bf2f((bf16_t)x1[e]), b = bf2f((bf16_t)x2[e]);
                x1[e] = (short)f2bf(a * cs[0] - b * cs[1]); x2[e] = (short)f2bf(a * cs[1] + b * cs[0]);
            }
            qr[8 + dd] = x1; qr[10 + dd] = x2;
        }
    }
    const int vb0 = (int)(uintptr_t)V_lds + v_rd_base(lane);
    const unsigned wbase = (unsigned)__builtin_amdgcn_readfirstlane(wid) * 1024u;
    const bf16_t* ksrc[3]; int kstr[3]; const bf16_t* vsrc[2];
#pragma unroll
    for (int pc = 0; pc < 3; ++pc) { const int bb = pc * 8192 + tid * 16, row = bb / 384, cB = (bb % 384) ^ ((((row >> 1) & 7)) << 4);
        if (cB < 256) { ksrc[pc] = Kn + (size_t)row * LDK + (cB >> 1); kstr[pc] = LDK; } else { ksrc[pc] = Kr + (size_t)row * LDKR + ((cB - 256) >> 1); kstr[pc] = LDKR; } }
#pragma unroll
    for (int pc = 0; pc < 2; ++pc) { const int bb = pc * 8192 + tid * 16, sub = bb >> 9, within = (bb & 511) >> 1, kk = (sub >> 2) * 8 + (within >> 5), c = (sub & 3) * 32 + (within & 31);
        const int k = (kk & ~0xC) | ((kk & 4) << 1) | ((kk & 8) >> 1); vsrc[pc] = Vh + (size_t)k * LDK + c; }
#define KVDMA(b, k0) do { _Pragma("unroll") for (int _p = 0; _p < 3; ++_p) __builtin_amdgcn_global_load_lds((const unsigned*)(ksrc[_p] + (size_t)(k0) * kstr[_p]), \
        (LAS unsigned*)(ldsl + 3 * SHM_V + (b) * SHM_K + _p * 8192 + wbase), 16, 0, 0); \
    _Pragma("unroll") for (int _p = 0; _p < 2; ++_p) __builtin_amdgcn_global_load_lds((const unsigned*)(vsrc[_p] + (size_t)(k0) * LDK), \
        (LAS unsigned*)(ldsl + (b) * SHM_V + _p * 8192 + wbase), 16, 0, 0); } while (0)
#define RESC(a) do { if (__any((a) < 1.f)) { \
    _Pragma("unroll") for (int d = 0; d < 4; ++d) _Pragma("unroll") for (int r = 0; r < 16; ++r) o[d][r] *= (a); } } while (0)
    f32x16 pA0, pA1, pB0, pB1; float mnA, mnB, alA, alB; bf16x8 pa0, pa1, pa2, pa3; const int NT = seq / KVBLK;
    KVDMA(0, 0); KVDMA(1, KVBLK); asm volatile("s_waitcnt vmcnt(0)" ::: "memory"); __syncthreads();
    qkt(pA0, pA1, K_lds, qr, r32, hi); partialSM(pA0, pA1, m_reg, mnA, alA);
    int bp = 0, bc = 1, bn = 2;
    for (int j = 1; j + 1 < NT; j += 2) {
        KVDMA(bn, (j + 1) * KVBLK);
        SBAR(); qkt(pB0, pB1, K_lds + bc * SHM_K, qr, r32, hi);
        finishSM(pA0, pA1, alA, l_reg, pa0, pa1, pa2, pa3); SBAR();
        pv_d0(o, vb0 + bp * SHM_V, pa0, pa1, pa2, pa3); partialSM(pB0, pB1, m_reg, mnB, alB);
        RESC(alB);
        asm volatile("s_waitcnt vmcnt(0)" ::: "memory"); __syncthreads();
        { const int t = bp; bp = bc; bc = bn; bn = t; }
        if (j + 2 < NT) KVDMA(bn, (j + 2) * KVBLK);
        SBAR(); qkt(pA0, pA1, K_lds + bc * SHM_K, qr, r32, hi);
        finishSM(pB0, pB1, alB, l_reg, pa0, pa1, pa2, pa3); SBAR();
        pv_d0(o, vb0 + bp * SHM_V, pa0, pa1, pa2, pa3); partialSM(pA0, pA1, m_reg, mnA, alA);
        RESC(alA);
        asm volatile("s_waitcnt vmcnt(0)" ::: "memory"); __syncthreads();
        { const int t = bp; bp = bc; bc = bn; bn = t; }
    }
    SBAR(); qkt(pB0, pB1, K_lds + bc * SHM_K, qr, r32, hi);
    finishSM(pA0, pA1, alA, l_reg, pa0, pa1, pa2, pa3); SBAR();
    pv_d0(o, vb0 + bp * SHM_V, pa0, pa1, pa2, pa3); partialSM(pB0, pB1, m_reg, mnB, alB);
    RESC(alB);
    finishSM(pB0, pB1, alB, l_reg, pa0, pa1, pa2, pa3); SBAR();
    pv_d0(o, vb0 + bc * SHM_V, pa0, pa1, pa2, pa3);
    {
        const float rl = __builtin_amdgcn_rcpf(l_reg);
        bf16_t* Ow = Ob + (size_t)(wid * QBLK + r32) * LDO + 4 * hi;
#pragma unroll
        for (int d0 = 0; d0 < 4; ++d0)
#pragma unroll
            for (int g = 0; g < 4; ++g) { u32x2 w; w.x = cvt_pk_bf16(o[d0][4 * g] * rl, o[d0][4 * g + 1] * rl); w.y = cvt_pk_bf16(o[d0][4 * g + 2] * rl, o[d0][4 * g + 3] * rl);
                *(u32x2*)(Ow + d0 * 32 + 8 * g) = w; }
    }
#undef KVDMA
#undef RESC
}
}


namespace gla {
#define KSWZ0(row, colB) ((row) * 256 + ((colB) ^ (((row) & 7) << 4)))
constexpr int L_Q = 0, L_K = 16384, L_V = 32768, L_B = 49152, L_ST = 81920, L_TOT = 114688, L_DEC = 115712;
#define GPK(L, H) (bf16x8){L[0], L[1], L[2], L[3], H[0], H[1], H[2], H[3]}
#define LDS_BARRIER() do { asm volatile("s_waitcnt lgkmcnt(0)" ::: "memory"); __builtin_amdgcn_s_barrier(); asm volatile("" ::: "memory"); } while (0)
__device__ __forceinline__ void phase(const Params& p, int j, int grp, unsigned char* shm) {
    using att::crow; using att::v_st; using att::v_rd_base; using att::v_rd_off; using att::tr_read;
    char* lds = (char*)shm;
    const bf16_t* proj = (const bf16_t*)(p.ws + OFF_ACT + GLA_PROJ);
    bf16_t* of = (bf16_t*)(p.ws + OFF_ACT + GLA_OF);
    bf16_t* ob = (bf16_t*)(p.ws + OFF_ACT + GLA_OB);
    const float* wup_all = p.in[11] + (size_t)j * 2 * 16 * 512;
    const float* bg_all = p.in[12] + (size_t)j * 2 * 512;
    const int tid = opaque_tid(), wid = __builtin_amdgcn_readfirstlane(tid >> 6), lane = tid & 63, r32 = lane & 31, hi = lane >> 5;
    const int ib = wid & 1, wq = wid >> 1;
    const int sr = tid >> 4, sc = (tid & 15) * 8, vst0 = v_st(sr, sc), vst1 = v_st(32 + sr, sc);
    float* tot = (float*)(lds + L_TOT); float* decay = (float*)(lds + L_DEC); float* Bt = (float*)(lds + L_B);
    const int nseq = grp == 0 ? 12 : 8, items = nseq * 16;
    for (int it = opaque_bid(); it < items; it += gridDim.x) {
        const int sl = (nseq - 1) - it / 16, rem = it % 16, h = rem >> 2, dir = (rem >> 1) & 1, dvh = rem & 1;
        int start, len;
        if (grp == 0 || sl < 4) { start = sl * 4096; len = 4096; } else { start = 16384 + (sl - 4) * 8192; len = 8192; }
        const int dcol = 32 * wq + r32;
        bf16x8 wf;
#pragma unroll
        for (int e = 0; e < 8; ++e) wf[e] = (short)f2bf(wup_all[(size_t)(dir * 16 + 8 * hi + e) * 512 + h * 128 + dcol]);
        const float bias_d = bg_all[dir * 512 + h * 128 + dcol];
        for (int i = tid; i < 2048; i += 512) *(u32x4*)(lds + L_ST + i * 16) = (u32x4){0u, 0u, 0u, 0u};
        f32x16 S0 = {}, S1 = {};
        bf16_t* odst = (dir ? ob : of) + h * 256 + dvh * 128;
        const bf16_t* qsrc = proj + h * 128 + sc;
        const bf16_t* ksrc = proj + 512 + h * 128 + sc;
        const bf16_t* vsrc = proj + 1024 + h * 256 + dvh * 128 + sc;
        const bf16_t* asrc = proj + 3072 + dir * 16 + 8 * hi;
        bf16x8 rq0, rq1, rk0, rk1, rv0, rv1, ra;
#define GLA_TOK(step) (start + (dir ? (len - 1 - (step)) : (step)))
#define GLA_LOAD(c) do { const size_t ta = (size_t)GLA_TOK((c) * 64 + sr) * 3328, tb = (size_t)GLA_TOK((c) * 64 + 32 + sr) * 3328; \
        rq0 = *(const bf16x8*)(qsrc + ta); rq1 = *(const bf16x8*)(qsrc + tb); rk0 = *(const bf16x8*)(ksrc + ta); rk1 = *(const bf16x8*)(ksrc + tb); \
        rv0 = *(const bf16x8*)(vsrc + ta); rv1 = *(const bf16x8*)(vsrc + tb); ra = *(const bf16x8*)(asrc + (size_t)GLA_TOK((c) * 64 + 32 * ib + r32) * 3328); } while (0)
        GLA_LOAD(0);
        __syncthreads();
        const int nch = len / 64;
        for (int c = 0; c < nch; ++c) {
            *(bf16x8*)(lds + L_V + vst0) = rv0; *(bf16x8*)(lds + L_V + vst1) = rv1;
            const bf16x8 cq0 = rq0, cq1 = rq1, ck0 = rk0, ck1 = rk1, af = ra;
            if (c + 1 < nch) GLA_LOAD(c + 1);
            {
                f32x16 z;
#pragma unroll
                for (int r = 0; r < 16; ++r) z[r] = bias_d;
                z = __builtin_amdgcn_mfma_f32_32x32x16_bf16(af, wf, z, 0, 0, 0);
                float la[16], tg[4], ug[4];
#pragma unroll
                for (int r = 0; r < 16; ++r) { const float zz = z[r] * 1.4426950408889634f;
                    la[r] = (fminf(zz, 0.f) - __builtin_amdgcn_logf(1.0f + __builtin_amdgcn_exp2f(-fabsf(zz)))) * 0.0625f; }
#pragma unroll
                for (int g = 0; g < 4; ++g) { tg[g] = (la[4 * g] + la[4 * g + 1]) + (la[4 * g + 2] + la[4 * g + 3]); ug[g] = get_xor32(tg[g], hi); }
                float run0 = 0.f;
#pragma unroll
                for (int g = 0; g < 4; ++g) {
                    float run = run0 + (hi ? ug[g] : 0.f);
#pragma unroll
                    for (int e = 0; e < 4; ++e) { run += la[4 * g + e]; Bt[(32 * ib + 8 * g + 4 * hi + e) * 128 + dcol] = run; }
                    run0 += tg[g] + ug[g];
                }
                if (hi == 0) tot[ib * 128 + dcol] = run0;
            }
            LDS_BARRIER();
            {
                const f32x4 t0a = *(const f32x4*)(tot + sc), t0b = *(const f32x4*)(tot + sc + 4);
                const f32x4 b0a = *(const f32x4*)(Bt + sr * 128 + sc), b0b = *(const f32x4*)(Bt + sr * 128 + sc + 4);
                const f32x4 b1a = *(const f32x4*)(Bt + (32 + sr) * 128 + sc) + t0a, b1b = *(const f32x4*)(Bt + (32 + sr) * 128 + sc + 4) + t0b;
                if (tid < 128) decay[tid] = __builtin_amdgcn_exp2f(tot[tid] + tot[128 + tid]);
                u32x4 qo0, ko0, qo1, ko1;
#define GLA_CVT(QO, KO, CQ, CK, BA, BB) do { const u32x4 _q = *reinterpret_cast<const u32x4*>(&CQ), _k = *reinterpret_cast<const u32x4*>(&CK); \
        _Pragma("unroll") for (int _w = 0; _w < 4; ++_w) { const float _b0 = _w < 2 ? BA[2 * _w] : BB[2 * _w - 4], _b1 = _w < 2 ? BA[2 * _w + 1] : BB[2 * _w - 3]; \
            const float _e0 = __builtin_amdgcn_exp2f(_b0), _e1 = __builtin_amdgcn_exp2f(_b1), _n0 = __builtin_amdgcn_exp2f(-_b0), _n1 = __builtin_amdgcn_exp2f(-_b1); \
            QO[_w] = cvt_pk_bf16(lo_bf(_q[_w]) * 0.08838834764831845f * _e0, hi_bf(_q[_w]) * 0.08838834764831845f * _e1); \
            KO[_w] = cvt_pk_bf16(lo_bf(_k[_w]) * _n0, hi_bf(_k[_w]) * _n1); } } while (0)
                GLA_CVT(qo0, ko0, cq0, ck0, b0a, b0b);
                GLA_CVT(qo1, ko1, cq1, ck1, b1a, b1b);
#undef GLA_CVT
                *(u32x4*)(lds + L_Q + KSWZ0(sr, sc * 2)) = qo0; *(u32x4*)(lds + L_Q + KSWZ0(32 + sr, sc * 2)) = qo1;
                *(u32x4*)(lds + L_K + vst0) = ko0; *(u32x4*)(lds + L_K + vst1) = ko1;
            }
            LDS_BARRIER();
            {
                bf16x8 qf[8];
#pragma unroll
                for (int d0 = 0; d0 < 8; ++d0) qf[d0] = *(const bf16x8*)(lds + L_Q + KSWZ0(32 * ib + r32, (d0 * 16 + hi * 8) * 2));
                f32x16 p0 = {}, p1 = {};
#pragma unroll
                for (int d0 = 0; d0 < 8; ++d0) { const bf16x8 kf = *(const bf16x8*)(lds + L_K + v_st(r32, d0 * 16 + hi * 8));
                    p0 = __builtin_amdgcn_mfma_f32_32x32x16_bf16(kf, qf[d0], p0, 0, 0, 0); }
                if (ib) {
#pragma unroll
                    for (int d0 = 0; d0 < 8; ++d0) { const bf16x8 kf = *(const bf16x8*)(lds + L_K + v_st(32 + r32, d0 * 16 + hi * 8));
                        p1 = __builtin_amdgcn_mfma_f32_32x32x16_bf16(kf, qf[d0], p1, 0, 0, 0); }
                }
#pragma unroll
                for (int r = 0; r < 16; ++r) { const bool keep = crow(r, hi) <= r32;
                    if (ib == 0) p0[r] = keep ? p0[r] : 0.f; else p1[r] = keep ? p1[r] : 0.f; }
                bf16x8 pa0, pa1, pa2, pa3;
#define GPK4(P, BASE, OUT) do { unsigned a0 = cvt_pk_bf16(P[BASE + 0], P[BASE + 1]), a1 = cvt_pk_bf16(P[BASE + 2], P[BASE + 3]);   \
    unsigned b0 = cvt_pk_bf16(P[BASE + 4], P[BASE + 5]), b1 = cvt_pk_bf16(P[BASE + 6], P[BASE + 7]);                              \
    auto r0 = __builtin_amdgcn_permlane32_swap(a0, b0, false, false); auto r1 = __builtin_amdgcn_permlane32_swap(a1, b1, false, false); \
    u32x4 w = {r0[0], r1[0], r0[1], r1[1]}; OUT = *reinterpret_cast<bf16x8*>(&w); } while (0)
                GPK4(p0, 0, pa0); GPK4(p0, 8, pa1); GPK4(p1, 0, pa2); GPK4(p1, 8, pa3);
#undef GPK4
                f32x16 o = {};
#pragma unroll
                for (int d0 = 0; d0 < 8; ++d0) { const bf16x8 sf = *(const bf16x8*)(lds + L_ST + KSWZ0(32 * wq + r32, (d0 * 16 + hi * 8) * 2));
                    o = __builtin_amdgcn_mfma_f32_32x32x16_bf16(sf, qf[d0], o, 0, 0, 0); }
                {
                    const int vbase = (int)(uintptr_t)(lds + L_V) + v_rd_base(lane) + wq * 512;
                    const s16x4 l0 = tr_read<v_rd_off(0, 0, 0)>(vbase), h0 = tr_read<v_rd_off(0, 0, 1)>(vbase), l1 = tr_read<v_rd_off(0, 1, 0)>(vbase), h1 = tr_read<v_rd_off(0, 1, 1)>(vbase);
                    const s16x4 l2 = tr_read<v_rd_off(0, 2, 0)>(vbase), h2 = tr_read<v_rd_off(0, 2, 1)>(vbase), l3 = tr_read<v_rd_off(0, 3, 0)>(vbase), h3 = tr_read<v_rd_off(0, 3, 1)>(vbase);
                    asm volatile("s_waitcnt lgkmcnt(0)" ::: "memory"); __builtin_amdgcn_sched_barrier(0);
                    o = __builtin_amdgcn_mfma_f32_32x32x16_bf16(GPK(l0, h0), pa0, o, 0, 0, 0);
                    o = __builtin_amdgcn_mfma_f32_32x32x16_bf16(GPK(l1, h1), pa1, o, 0, 0, 0);
                    o = __builtin_amdgcn_mfma_f32_32x32x16_bf16(GPK(l2, h2), pa2, o, 0, 0, 0);
                    o = __builtin_amdgcn_mfma_f32_32x32x16_bf16(GPK(l3, h3), pa3, o, 0, 0, 0);
                }
                {
                    bf16_t* orow = odst + (size_t)GLA_TOK(c * 64 + 32 * ib + r32) * 1024 + 32 * wq + 4 * hi;
#pragma unroll
                    for (int g = 0; g < 4; ++g) { u32x2 w; w.x = cvt_pk_bf16(o[4 * g], o[4 * g + 1]); w.y = cvt_pk_bf16(o[4 * g + 2], o[4 * g + 3]); *(u32x2*)(orow + 8 * g) = w; }
                }
            }
            {
                const int kbase = (int)(uintptr_t)(lds + L_K) + v_rd_base(lane) + wq * 512;
                const int vb0 = (int)(uintptr_t)(lds + L_V) + v_rd_base(lane) + (2 * ib) * 512, vb1 = vb0 + 512;
                const s16x4 kl0 = tr_read<v_rd_off(0, 0, 0)>(kbase), kh0 = tr_read<v_rd_off(0, 0, 1)>(kbase), kl1 = tr_read<v_rd_off(0, 1, 0)>(kbase), kh1 = tr_read<v_rd_off(0, 1, 1)>(kbase);
                const s16x4 kl2 = tr_read<v_rd_off(0, 2, 0)>(kbase), kh2 = tr_read<v_rd_off(0, 2, 1)>(kbase), kl3 = tr_read<v_rd_off(0, 3, 0)>(kbase), kh3 = tr_read<v_rd_off(0, 3, 1)>(kbase);
                const s16x4 al0 = tr_read<v_rd_off(0, 0, 0)>(vb0), ah0 = tr_read<v_rd_off(0, 0, 1)>(vb0), al1 = tr_read<v_rd_off(0, 1, 0)>(vb0), ah1 = tr_read<v_rd_off(0, 1, 1)>(vb0);
                const s16x4 al2 = tr_read<v_rd_off(0, 2, 0)>(vb0), ah2 = tr_read<v_rd_off(0, 2, 1)>(vb0), al3 = tr_read<v_rd_off(0, 3, 0)>(vb0), ah3 = tr_read<v_rd_off(0, 3, 1)>(vb0);
                const s16x4 bl0 = tr_read<v_rd_off(0, 0, 0)>(vb1), bh0 = tr_read<v_rd_off(0, 0, 1)>(vb1), bl1 = tr_read<v_rd_off(0, 1, 0)>(vb1), bh1 = tr_read<v_rd_off(0, 1, 1)>(vb1);
                const s16x4 bl2 = tr_read<v_rd_off(0, 2, 0)>(vb1), bh2 = tr_read<v_rd_off(0, 2, 1)>(vb1), bl3 = tr_read<v_rd_off(0, 3, 0)>(vb1), bh3 = tr_read<v_rd_off(0, 3, 1)>(vb1);
                float dk[16];
#pragma unroll
                for (int r = 0; r < 16; ++r) dk[r] = decay[32 * wq + crow(r, hi)];
                asm volatile("s_waitcnt lgkmcnt(0)" ::: "memory"); __builtin_amdgcn_sched_barrier(0);
                S0 = __builtin_amdgcn_mfma_f32_32x32x16_bf16(GPK(kl0, kh0), GPK(al0, ah0), S0, 0, 0, 0);
                S1 = __builtin_amdgcn_mfma_f32_32x32x16_bf16(GPK(kl0, kh0), GPK(bl0, bh0), S1, 0, 0, 0);
                S0 = __builtin_amdgcn_mfma_f32_32x32x16_bf16(GPK(kl1, kh1), GPK(al1, ah1), S0, 0, 0, 0);
                S1 = __builtin_amdgcn_mfma_f32_32x32x16_bf16(GPK(kl1, kh1), GPK(bl1, bh1), S1, 0, 0, 0);
                S0 = __builtin_amdgcn_mfma_f32_32x32x16_bf16(GPK(kl2, kh2), GPK(al2, ah2), S0, 0, 0, 0);
                S1 = __builtin_amdgcn_mfma_f32_32x32x16_bf16(GPK(kl2, kh2), GPK(bl2, bh2), S1, 0, 0, 0);
                S0 = __builtin_amdgcn_mfma_f32_32x32x16_bf16(GPK(kl3, kh3), GPK(al3, ah3), S0, 0, 0, 0);
                S1 = __builtin_amdgcn_mfma_f32_32x32x16_bf16(GPK(kl3, kh3), GPK(bl3, bh3), S1, 0, 0, 0);
#pragma unroll
                for (int r = 0; r < 16; ++r) { S0[r] *= dk[r]; S1[r] *= dk[r]; }
            }
            LDS_BARRIER();
#pragma unroll
            for (int g = 0; g < 4; ++g) {
                const int d0 = 32 * wq + 8 * g + 4 * hi;
                u32x2 w0; w0.x = cvt_pk_bf16(S0[4 * g], S0[4 * g + 1]); w0.y = cvt_pk_bf16(S0[4 * g + 2], S0[4 * g + 3]);
                u32x2 w1; w1.x = cvt_pk_bf16(S1[4 * g], S1[4 * g + 1]); w1.y = cvt_pk_bf16(S1[4 * g + 2], S1[4 * g + 3]);
                *(u32x2*)(lds + L_ST + KSWZ0(64 * ib + r32, 2 * d0)) = w0;
                *(u32x2*)(lds + L_ST + KSWZ0(64 * ib + 32 + r32, 2 * d0)) = w1;
            }
        }
        __syncthreads();
#undef GLA_LOAD
#undef GLA_TOK
    }
}
}

__device__ __forceinline__ void phase_mla_attn(const Params& p, int grp, unsigned char* shm) {
    const bf16_t* Q = (const bf16_t*)(p.ws + OFF_ACT + MLA_Q);
    const bf16_t* Kn = (const bf16_t*)(p.ws + OFF_ACT + MLA_KN);
    const bf16_t* Kr = (const bf16_t*)(p.ws + OFF_ACT + MLA_KR);
    const bf16_t* V = (const bf16_t*)(p.ws + OFF_ACT + MLA_V);
    bf16_t* O = (bf16_t*)(p.ws + OFF_ACT + MLA_O);
    const f32x2* rope = (const f32x2*)(p.ws + OFF_ROPE);
    const int nb = gridDim.x, per = nb >> 3, bid = opaque_bid(), xcd = bid & 7, slot = bid >> 3;
    constexpr int ITEMS = 1536;
    for (int r = 0;; ++r) {
        const int vv = r * nb + xcd * per + slot;
        if (vv >= ITEMS) break;
        int start, len, h, qb;
        if (grp == 0) { const int sl = vv >> 7; h = (vv & 127) >> 4; qb = vv & 15; start = sl * 4096; len = 4096; }
        else if (vv < 1024) { const int sl = vv >> 8; h = (vv & 255) >> 5; qb = vv & 31; start = 16384 + sl * 8192; len = 8192; }
        else { const int v2 = vv - 1024, sl = v2 >> 7; h = (v2 & 127) >> 4; qb = v2 & 15; start = sl * 4096; len = 4096; }
        const size_t q0 = (size_t)(start + qb * 256);
        att::body(Q + q0 * 1536 + h * 192, Kn + (size_t)start * 1024 + h * 128, Kr + (size_t)start * 64, V + (size_t)start * 1024 + h * 128,
                  O + q0 * 1024 + h * 128, len, qb * 256, rope, (char*)shm, (LAS unsigned char*)shm);
        __syncthreads();
    }
}


#define XB_TMO      128
#define XB_XCNT(j)  (256  + 64 * (j))
#define XB_XSUB(j)  (1280 + 64 * (j))
#define XB_XGEN(j)  (2304 + 64 * (j))
#define XB_TOP      3328
#define XB_TOPGEN   3392
#define XCD_BAR_WORDS 3456
#define XB_SPIN_CAP (1u << 23)
__device__ __forceinline__ unsigned xb_ld(unsigned* p)              { return __hip_atomic_load(p, __ATOMIC_RELAXED, __HIP_MEMORY_SCOPE_AGENT); }
__device__ __forceinline__ unsigned xb_add(unsigned* p, unsigned v) { return __hip_atomic_fetch_add(p, v, __ATOMIC_RELAXED, __HIP_MEMORY_SCOPE_AGENT); }
__device__ __forceinline__ unsigned xb_xcc_id() { return (unsigned)__builtin_amdgcn_s_getreg((3 << 11) | 20) & 0xFu; }
#define XB_SPIN(cond, bar) do { unsigned _sp = 0; while (cond) { __builtin_amdgcn_s_sleep(1); \
    if ((++_sp & 255u) == 0u) { if (xb_ld(&(bar)[XB_TMO])) break; if (_sp > XB_SPIN_CAP) { atomicAdd(&(bar)[XB_TMO], 1u); break; } } } } while (0)
__device__ __forceinline__ void xcd_barrier_post(unsigned* bar) { if (opaque_tid() == 0) (void)xb_add(&bar[XB_XCNT(xb_xcc_id())], 1u); }
__device__ __forceinline__ void xcd_barrier_complete(unsigned* bar, unsigned x, unsigned& nloc, unsigned& nx) {
    const unsigned G = gridDim.x;
    unsigned sum, cnt, mine, sp = 0u;
    for (;;) {
        sum = 0u; cnt = 0u; mine = 0u;
#pragma unroll
        for (unsigned j = 0; j < 16; ++j) { const unsigned c = xb_ld(&bar[XB_XCNT(j)]); sum += c; cnt += (c > 0u) ? 1u : 0u; mine = (j == x) ? c : mine; }
        if (sum == G) break;
        __builtin_amdgcn_s_sleep(1);
        if ((++sp & 255u) == 0u) { if (xb_ld(&bar[XB_TMO])) break; if (sp > XB_SPIN_CAP) { atomicAdd(&bar[XB_TMO], 1u); break; } }
    }
    nloc = mine > 0u ? mine : 1u; nx = cnt > 0u ? cnt : 1u;
}
__device__ __forceinline__ void xcd_barrier(unsigned* bar, volatile LAS unsigned* st) {
    asm volatile("s_waitcnt vmcnt(0)" ::: "memory");
    __syncthreads();
    if (opaque_tid() == 0) {
        const unsigned x = xb_xcc_id();
        __builtin_amdgcn_s_waitcnt(0);
        unsigned nloc = st[0], nx = st[1];
        if (nloc == 0u) { xcd_barrier_complete(bar, x, nloc, nx); st[0] = nloc; st[1] = nx; }
        const unsigned old = xb_add(&bar[XB_XSUB(x)], 1u);
        const unsigned gen = old / nloc;
        if (old + 1u == (gen + 1u) * nloc) {
            __builtin_amdgcn_fence(__ATOMIC_RELEASE, "agent");
            asm volatile("s_waitcnt vmcnt(0)" ::: "memory");
            const unsigned og = xb_add(&bar[XB_TOP], 1u);
            const unsigned tg = og / nx;
            if (og + 1u == (tg + 1u) * nx) xb_add(&bar[XB_TOPGEN], 1u);
            else XB_SPIN(xb_ld(&bar[XB_TOPGEN]) == tg, bar);
            __builtin_amdgcn_fence(__ATOMIC_ACQUIRE, "agent");
            xb_add(&bar[XB_XGEN(x)], 1u);
            asm volatile("s_waitcnt vmcnt(0)" ::: "memory");
        } else {
            XB_SPIN(xb_ld(&bar[XB_XGEN(x)]) == gen, bar);
            __builtin_amdgcn_fence(__ATOMIC_ACQUIRE, "agent");
            asm volatile("s_waitcnt vmcnt(0)" ::: "memory");
        }
    }
    __syncthreads();
}

#ifndef PH_MASK
#define PH_MASK 0xFFFFFF
#endif
#define PH(bit) if constexpr ((PH_MASK >> (bit)) & 1)
#ifndef PROBE_DBL
#define PROBE_DBL 0
#endif
#define GSYNC() do { xcd_barrier(xbar, xst); if constexpr ((PROBE_DBL >> 4) & 1) xcd_barrier(xbar, xst); } while (0)
#define DBL(bit) for (int _rep = 0; _rep < (((PROBE_DBL >> (bit)) & 1) ? 2 : 1); ++_rep)
__global__ __launch_bounds__(512, 2) void mega_kernel(Params p) {
    extern __shared__ __attribute__((aligned(16))) unsigned char shm[];
    cg::grid_group grid = cg::this_grid();
    LAS unsigned char* lds = (LAS unsigned char*)shm;
    bf16_t* Wb = (bf16_t*)(p.ws + OFF_W);
    const float* modb = (const float*)(p.ws + OFF_MOD);
    bf16_t* Hb = (bf16_t*)p.out;
    bf16_t* ACT = (bf16_t*)(p.ws + OFF_ACT);
    float* XF = (float*)(p.ws + OFF_H);
    unsigned* xbar = (unsigned*)(p.ws + OFF_BAR);
    volatile LAS unsigned* xst = (volatile LAS unsigned*)(lds + LDS_MAIN);
    if (opaque_tid() == 0) { xst[0] = 0u; xst[1] = 0u; }
    __syncthreads();
    xcd_barrier_post(xbar);

    DBL(5) {
    PH(0) prep_mod(p, shm);
    __syncthreads();
    PH(1) prep_rope(p);
    PH(2) prep_weights(p, shm);
    GSYNC();
    if (p.ws == nullptr) grid.sync();
    phase_tb(p, shm);
    phase_prenorm(p);
    GSYNC();
    }

    float* ssqb = (float*)(p.ws + OFF_SSQ);
    const float* tball = (const float*)(p.ws + OFF_TB);
#pragma unroll 1
    for (int l = 0; l < 4; ++l) {
        const float* modl = modb + (size_t)l * NSEQ * MODW;
        const int mj = l >> 1;
        const bf16_t* wmix = Wb + W_FFN_TOTAL + (size_t)mj * W_MIX_STRIDE;
#pragma unroll 1
        for (int w = 0; w < 2; ++w) {
            const int inst = 3 * l + (w ? 2 : 0), mi = w ? 6 : 0;
            float* ssq_cur = ssqb + (size_t)(inst & 1) * T_ALL * 16; float* ssq_nxt = ssqb + (size_t)((inst + 1) & 1) * T_ALL * 16;
            const bf16_t* wgu = Wb + (size_t)(l * 2 + w) * W_FFN_STRIDE;
            DBL(1) PH(5) { pg8::EpiGateUp E; E.O = ACT; E.ssq = ssq_cur; E.tb = tball + (size_t)(l * 2 + w) * TB_FFN_SZ; run_gemm(lds, Hb, 1024, wgu, 1024, T_ALL, 5632, 1024, E); }
            GSYNC();
            {
                const bool last = (l == 3 && w == 1);
                const int nl = w ? l + 1 : l;
                const float* gprev = p.in[6] + (size_t)(l * 3 + (w ? 2 : 0)) * 1024; const float* scprev = modl + (mi + 1) * 1024;
                if (last) { pg8::EpiResidLast E; E.XS = Hb; E.gprev = gprev; E.scprev = scprev; E.gate = modl + (mi + 2) * 1024; E.coef = 0.5f; E.lo = XF; E.hi_ = p.out;
                    run_gemm(lds, ACT, DFF, wgu + SZ_GU, DFF, T_ALL, 1024, DFF, E); }
                else { pg8::EpiResid E; E.gate = modl + (mi + 2) * 1024; E.coef = 0.5f; E.tile0 = 0; E.gprev = gprev; E.scprev = scprev;
                    E.XS = Hb; E.gnext = p.in[6] + (size_t)(nl * 3 + (w ? 0 : 1)) * 1024;
                    E.scnext = modb + (size_t)nl * NSEQ * MODW + (w ? 1 : 4) * 1024; E.ssq = ssq_nxt;
                    PH(6) run_gemm(lds, ACT, DFF, wgu + SZ_GU, DFF, T_ALL, 1024, DFF, E); }
            }
            GSYNC();
            if (w == 0) {
                float* ssq_m = ssq_nxt;
                float* ssq_f2 = ssq_cur;
#pragma unroll 1
                for (int grp = 0; grp < 2; ++grp) {
                    const bf16_t* hg = Hb + (size_t)grp * TG * 1024;
                    const int t0 = grp * (TG / 256);
                    if ((l & 1) == 0) {
                        PH(7) { pg8::EpiBf16N E; E.O = (bf16_t*)(p.ws + OFF_ACT + GLA_PROJ); E.ldc = 3328; E.ssq = ssq_m + (size_t)grp * TG * 16; E.tb = tball + 8 * TB_FFN_SZ + (size_t)mj * TB_PROJ_SZ; E.ldtb = 3328; E.tile0 = t0;
                            run_gemm(lds, hg, 1024, wmix, 1024, TG, 3328, 1024, E); }
                        GSYNC();
                        DBL(2) PH(8) gla::phase(p, mj, grp, shm);
                        GSYNC();
                        PH(9) phase_gla_combine(p, mj, grp);
                        GSYNC();
                        PH(13) { pg8::EpiResid E; E.gate = modl + 5 * 1024; E.coef = 1.0f; E.tile0 = t0; E.gprev = p.in[6] + (size_t)(l * 3 + 1) * 1024; E.scprev = modl + 4 * 1024;
                          E.XS = Hb + (size_t)grp * TG * 1024; E.gnext = p.in[6] + (size_t)(l * 3 + 2) * 1024; E.scnext = modl + 7 * 1024; E.ssq = ssq_f2 + (size_t)grp * TG * 16;
                          run_gemm(lds, (const bf16_t*)(p.ws + OFF_ACT + GLA_OF), 1024, wmix + SZ_GIN, 1024, TG, 1024, 1024, E); }
                        GSYNC();
                    } else {
                        const bf16_t* w_min = wmix + SZ_GIN + SZ_GOUT; const bf16_t* w_uq = w_min + SZ_MIN; const bf16_t* w_ukv = w_uq + SZ_UQ; const bf16_t* w_mout = w_ukv + SZ_UKV;
                        PH(14) { pg8::EpiBf16N E; E.O = (bf16_t*)(p.ws + OFF_ACT + MLA_CIN); E.ldc = 512; E.ssq = ssq_m + (size_t)grp * TG * 16; E.tb = tball + 8 * TB_FFN_SZ + 2 * TB_PROJ_SZ + (size_t)mj * TB_CIN_SZ; E.ldtb = 512; E.tile0 = t0;
                            run_gemm(lds, hg, 1024, w_min, 1024, TG, 512, 1024, E); }
                        GSYNC();
                        PH(10) phase_mla_normrope(p, mj, grp);
                        GSYNC();
                        const bf16_t* cn = (const bf16_t*)(p.ws + OFF_ACT + MLA_CN);
                        PH(15) { pg8::EpiBf16 E; E.O = (bf16_t*)(p.ws + OFF_ACT + MLA_Q); E.ldc = 1536; run_gemm(lds, cn, 512, w_uq, 256, TG, 1536, 256, E); }
                        PH(12) { pg8::EpiKV E; E.Kn = (bf16_t*)(p.ws + OFF_ACT + MLA_KN); E.V = (bf16_t*)(p.ws + OFF_ACT + MLA_V); run_gemm(lds, cn + 256, 512, w_ukv, 256, TG, 2048, 256, E); }
                        GSYNC();
                        DBL(0) PH(11) phase_mla_attn(p, grp, shm);
                        GSYNC();
                        PH(16) { pg8::EpiResid E; E.gate = modl + 5 * 1024; E.coef = 1.0f; E.tile0 = t0; E.gprev = p.in[6] + (size_t)(l * 3 + 1) * 1024; E.scprev = modl + 4 * 1024;
                          E.XS = Hb + (size_t)grp * TG * 1024; E.gnext = p.in[6] + (size_t)(l * 3 + 2) * 1024; E.scnext = modl + 7 * 1024; E.ssq = ssq_f2 + (size_t)grp * TG * 16;
                          run_gemm(lds, (const bf16_t*)(p.ws + OFF_ACT + MLA_O), 1024, w_mout, 1024, TG, 1024, 1024, E); }
                        GSYNC();
                    }
                }
            }
        }
    }
    const float* fin = modb + 4ull * NSEQ * MODW;
    phase_final(XF, p.out, p.in[23], fin, fin + 1024, 2048);
}

extern "C" void kernel_launch(void* const* d_in, const int* in_sizes, int n_in, void* d_out, int out_size, void* d_ws, size_t ws_size, hipStream_t stream) {
    static int grid_blocks = 0;
    if (!grid_blocks) {
        if (n_in != 24 || (size_t)out_size != (size_t)T_ALL * 1024 || ws_size < WS_NEED) {
            fprintf(stderr, "kernel_launch: unexpected shapes: n_in %d out %d ws %zu (need %zu)\n", n_in, out_size, ws_size, (size_t)WS_NEED);
            return;
        }
        if (hipFuncSetAttribute((const void*)mega_kernel, hipFuncAttributeMaxDynamicSharedMemorySize, LDS_BYTES) != hipSuccess) { fprintf(stderr, "kernel_launch: LDS attribute failed\n"); return; }
        int dev = 0, cus = 0, per_cu = 0;
        hipGetDevice(&dev);
        hipDeviceGetAttribute(&cus, hipDeviceAttributeMultiprocessorCount, dev);
        hipOccupancyMaxActiveBlocksPerMultiprocessor(&per_cu, mega_kernel, 512, LDS_BYTES);
        if (per_cu < 1) { fprintf(stderr, "kernel_launch: occupancy 0\n"); return; }
        grid_blocks = cus;
    }
    Params p{};
    for (int i = 0; i < 24; ++i) p.in[i] = (const float*)d_in[i];
    p.out = (float*)d_out; p.ws = (unsigned char*)d_ws;
    hipMemsetAsync((unsigned char*)d_ws + OFF_BAR, 0, XCD_BAR_WORDS * sizeof(unsigned), stream);
    void* args[] = {&p};
    hipError_t e = hipLaunchCooperativeKernel((void*)mega_kernel, dim3(grid_blocks), dim3(512), args, LDS_BYTES, stream);
    if (e != hipSuccess) fprintf(stderr, "cooperative launch failed: %s (grid %d)\n", hipGetErrorString(e), grid_blocks);
}
```
